# Optimizing an MI355X kernel written in HIP

```python
import math
import jax, jax.numpy as jnp
from jax import lax
import numpy as np

D_MODEL = 2048
BATCH = 1
SEQ = 16384
DEPTH = 2

HEAD_DIM_A = 128
HEADS_PER_GROUP_A = 4
DILATED_GROUPS = ((128, 1), (512, 4), (2048, 16))
N_GROUPS_A = len(DILATED_GROUPS)
N_HEADS_A = N_GROUPS_A * HEADS_PER_GROUP_A
WIDTH_A = N_HEADS_A * HEAD_DIM_A
OUT_WIDTH_A = HEADS_PER_GROUP_A * HEAD_DIM_A
N_HEADS_B = 16
QK_NOPE = 128
QK_ROPE = 64
V_DIM = 128
Q_LORA = 512
KV_LORA = 512
QK_DIM_B = QK_NOPE + QK_ROPE
OUT_WIDTH_B = N_HEADS_B * V_DIM
N_BRANCH = 2
N_IN = 3 * WIDTH_A + Q_LORA + KV_LORA + QK_ROPE + N_BRANCH * D_MODEL
D_FF = 5632
CONV_WIDTH = 3
ROPE_THETA = 10000.0
EPS = 1e-6
Q_BLOCK = 128

kernel_name = "hybrid_dilated_mla_convffn_encoder"


def rms_norm(x, g):
    xf = x.astype(jnp.float32)
    y = xf * lax.rsqrt(jnp.mean(xf * xf, axis=-1, keepdims=True) + EPS)
    return (y * g.astype(jnp.float32)).astype(x.dtype)


def rope(x, positions):
    dim = x.shape[-1]
    inv_freq = 1.0 / (ROPE_THETA ** (jnp.arange(0, dim, 2, dtype=jnp.float32) / dim))
    ang = positions.astype(jnp.float32)[..., None] * inv_freq
    cos = jnp.cos(ang)[:, :, None, :]
    sin = jnp.sin(ang)[:, :, None, :]
    xf = x.astype(jnp.float32)
    x1, x2 = xf[..., : dim // 2], xf[..., dim // 2:]
    out = jnp.concatenate([x1 * cos - x2 * sin, x2 * cos + x1 * sin], axis=-1)
    return out.astype(x.dtype)


def dilated_window_attention(q, k, v, window, dilation):
    B, S, H, hd = q.shape
    d = dilation
    w = window // (2 * d)
    L = S // d
    nb = -(-L // w)
    Lp = nb * w
    G = B * d

    def to_sub(t):
        return t.reshape(B, L, d, H, hd).transpose(0, 2, 1, 3, 4).reshape(G, L, H, hd)

    def windows(t):
        tp = jnp.pad(t, ((0, 0), (w, Lp - L + w), (0, 0), (0, 0))).reshape(G, nb + 2, w, H, hd)
        return jnp.concatenate([tp[:, :-2], tp[:, 1:-1], tp[:, 2:]], axis=2)

    qb = jnp.pad(to_sub(q), ((0, 0), (0, Lp - L), (0, 0), (0, 0))).reshape(G, nb, w, H, hd)
    kw = windows(to_sub(k))
    vw = windows(to_sub(v))

    start = jnp.arange(nb)[:, None] * w
    qi = start + jnp.arange(w)[None, :]
    kj = start - w + jnp.arange(3 * w)[None, :]
    dist = kj[:, None, :] - qi[:, :, None]
    valid = (jnp.abs(dist) <= w) & (kj[:, None, :] >= 0) & (kj[:, None, :] < L)

    s = jnp.einsum('gnqhd,gnkhd->ghnqk', qb, kw, preferred_element_type=jnp.float32) * (hd ** -0.5)
    s = jnp.where(valid, s, -jnp.inf)
    m = jnp.max(s, axis=-1, keepdims=True)
    p = jnp.exp(s - m)
    den = jnp.sum(p, axis=-1, keepdims=True)
    o = jnp.einsum('ghnqk,gnkhd->gnqhd', p.astype(v.dtype), vw, preferred_element_type=jnp.float32)
    o = o / den.transpose(0, 2, 3, 1, 4)
    lse = (m + jnp.log(den))[..., 0].transpose(0, 2, 3, 1)

    o = o.reshape(G, Lp, H, hd)[:, :L].reshape(B, d, L, H, hd).transpose(0, 2, 1, 3, 4).reshape(B, S, H, hd)
    lse = lse.reshape(G, Lp, H)[:, :L].reshape(B, d, L, H).transpose(0, 2, 1, 3).reshape(B, S, H)
    return o, lse


def dense_attention(q, k, v, scale):
    B, S, H, dq = q.shape
    dv = v.shape[-1]
    nq = S // Q_BLOCK
    qb = q.reshape(B, nq, Q_BLOCK, H, dq).transpose(1, 0, 2, 3, 4)

    def block(qi):
        s = jnp.einsum('bqhd,bkhd->bhqk', qi, k, preferred_element_type=jnp.float32) * scale
        p = jax.nn.softmax(s, axis=-1)
        o = jnp.einsum('bhqk,bkhd->bqhd', p.astype(v.dtype), v, preferred_element_type=jnp.float32)
        return o.astype(v.dtype)

    out = lax.map(block, qb)
    return out.transpose(1, 0, 2, 3, 4).reshape(B, S, H, dv)


def centred_depthwise_conv(h, w, b):
    S = h.shape[1]
    pad = CONV_WIDTH // 2
    hp = jnp.pad(h, ((0, 0), (pad, CONV_WIDTH - 1 - pad), (0, 0)))
    out = b
    for t in range(CONV_WIDTH):
        out = out + hp[:, t:t + S] * w[t]
    return out


def setup_inputs(seed: int = 0) -> dict:
    key = jax.random.key(seed)
    ks = jax.random.split(key, 20)

    def nrm(k, shape, scale):
        return jax.random.normal(k, shape, jnp.float32) * scale

    x = nrm(ks[0], (BATCH, SEQ, D_MODEL), 1.0)
    offset = jax.random.randint(ks[1], (BATCH, 1), 0, 1024, dtype=jnp.int32)
    positions = (offset + jnp.arange(SEQ, dtype=jnp.int32)[None, :]).astype(jnp.int32)
    return {
        "x": x,
        "positions": positions,
        "norm_mix": 1.0 + nrm(ks[2], (DEPTH, D_MODEL), 0.02),
        "w_in": nrm(ks[3], (DEPTH, D_MODEL, N_IN), D_MODEL ** -0.5),
        "b_gate": nrm(ks[4], (DEPTH, N_BRANCH, D_MODEL), 0.02),
        "norm_q": 1.0 + nrm(ks[5], (DEPTH, Q_LORA), 0.02),
        "w_uq": nrm(ks[6], (DEPTH, Q_LORA, N_HEADS_B * QK_DIM_B), Q_LORA ** -0.5),
        "norm_kv": 1.0 + nrm(ks[7], (DEPTH, KV_LORA), 0.02),
        "w_ukv": nrm(ks[8], (DEPTH, KV_LORA, N_HEADS_B * (QK_NOPE + V_DIM)), KV_LORA ** -0.5),
        "w_oa": nrm(ks[9], (DEPTH, OUT_WIDTH_A, D_MODEL), OUT_WIDTH_A ** -0.5),
        "w_ob": nrm(ks[10], (DEPTH, OUT_WIDTH_B, D_MODEL), OUT_WIDTH_B ** -0.5),
        "w_out": nrm(ks[11], (DEPTH, D_MODEL, D_MODEL), D_MODEL ** -0.5),
        "norm_ffn": 1.0 + nrm(ks[12], (DEPTH, D_MODEL), 0.02),
        "w_up": nrm(ks[13], (DEPTH, D_MODEL, 2 * D_FF), D_MODEL ** -0.5),
        "conv_w": nrm(ks[14], (DEPTH, CONV_WIDTH, 2 * D_FF), CONV_WIDTH ** -0.5),
        "conv_b": nrm(ks[15], (DEPTH, 2 * D_FF), 0.02),
        "w_down": nrm(ks[16], (DEPTH, D_FF, D_MODEL), D_FF ** -0.5),
        "norm_final": 1.0 + nrm(ks[17], (D_MODEL,), 0.02),
    }


def reference(x, positions, norm_mix, w_in, b_gate, norm_q, w_uq, norm_kv, w_ukv,
              w_oa, w_ob, w_out, norm_ffn, w_up, conv_w, conv_b, w_down, norm_final):
    B, S, D = x.shape
    o_qa, o_ka, o_va = 0, WIDTH_A, 2 * WIDTH_A
    o_ql = 3 * WIDTH_A
    o_kvl = o_ql + Q_LORA
    o_kr = o_kvl + KV_LORA
    o_g = o_kr + QK_ROPE

    for l in range(DEPTH):
        h = rms_norm(x, norm_mix[l])
        p = h @ w_in[l]

        qa = rope(p[..., o_qa:o_qa + WIDTH_A].reshape(B, S, N_HEADS_A, HEAD_DIM_A), positions)
        ka = rope(p[..., o_ka:o_ka + WIDTH_A].reshape(B, S, N_HEADS_A, HEAD_DIM_A), positions)
        va = p[..., o_va:o_va + WIDTH_A].reshape(B, S, N_HEADS_A, HEAD_DIM_A)
        outs, lses = [], []
        for gi, (window, dilation) in enumerate(DILATED_GROUPS):
            hs = slice(gi * HEADS_PER_GROUP_A, (gi + 1) * HEADS_PER_GROUP_A)
            o_g_i, lse_g_i = dilated_window_attention(qa[:, :, hs], ka[:, :, hs], va[:, :, hs], window, dilation)
            outs.append(o_g_i)
            lses.append(lse_g_i)
        wgt = jax.nn.softmax(jnp.stack(lses, axis=0), axis=0)
        oa = jnp.sum(wgt[..., None] * jnp.stack(outs, axis=0), axis=0).astype(x.dtype)
        ya = oa.reshape(B, S, OUT_WIDTH_A) @ w_oa[l]

        cq = rms_norm(p[..., o_ql:o_ql + Q_LORA], norm_q[l]) @ w_uq[l]
        cq = cq.reshape(B, S, N_HEADS_B, QK_DIM_B)
        q_b = jnp.concatenate([cq[..., :QK_NOPE], rope(cq[..., QK_NOPE:], positions)], axis=-1)
        ckv = rms_norm(p[..., o_kvl:o_kvl + KV_LORA], norm_kv[l]) @ w_ukv[l]
        ckv = ckv.reshape(B, S, N_HEADS_B, QK_NOPE + V_DIM)
        k_pe = rope(p[..., o_kr:o_kr + QK_ROPE][:, :, None, :], positions)
        k_b = jnp.concatenate([ckv[..., :QK_NOPE],
                               jnp.broadcast_to(k_pe, (B, S, N_HEADS_B, QK_ROPE))], axis=-1)
        v_b = ckv[..., QK_NOPE:]
        ob = dense_attention(q_b, k_b, v_b, QK_DIM_B ** -0.5)
        yb = ob.reshape(B, S, OUT_WIDTH_B) @ w_ob[l]

        gates = jax.nn.sigmoid(p[..., o_g:o_g + N_BRANCH * D].reshape(B, S, N_BRANCH, D) + b_gate[l])
        merged = gates[:, :, 0] * ya + gates[:, :, 1] * yb
        x = x + merged @ w_out[l]

        h2 = rms_norm(x, norm_ffn[l])
        u = centred_depthwise_conv(h2 @ w_up[l], conv_w[l], conv_b[l])
        x = x + (jax.nn.silu(u[..., :D_FF]) * u[..., D_FF:]) @ w_down[l]

    return rms_norm(x, norm_final)
```

```cpp
#include <hip/hip_runtime.h>
#include <hip/hip_cooperative_groups.h>
#include <cstdio>
#include <cstdint>
#include <cmath>
namespace cg = cooperative_groups;

constexpr int S_ = 16384, DM = 2048, DEPTH_ = 2;
constexpr int WA = 1536, QLORA = 512, KVLORA = 512, QKROPE = 64, NIN = 9792, NINP = 9984;
constexpr int DFF = 5632;
constexpr float EPS_ = 1e-6f;
constexpr size_t MiB = 1u << 20;
constexpr size_t WS_ROPEA = 1 * MiB, WS_ROPEB = 9 * MiB, WS_RSTD = 13 * MiB;
constexpr size_t WS_WUP = 16 * MiB, WS_WDN = 60 * MiB, WS_WIN = 82 * MiB, WS_WUQ = 121 * MiB, WS_WUKV = 124 * MiB, WS_WOA = 128 * MiB, WS_WOB = 130 * MiB, WS_WOUT = 138 * MiB;
constexpr size_t WS_H = 146 * MiB;
constexpr size_t WS_QA = 210 * MiB, WS_KA = 258 * MiB, WS_VA = 306 * MiB;
constexpr size_t WS_KN = 210 * MiB, WS_VB = 274 * MiB, WS_OA = 338 * MiB;
constexpr size_t WS_OG = 354 * MiB, WS_QL = 402 * MiB;
constexpr size_t WS_T = 354 * MiB;
constexpr size_t WS_KVL = 418 * MiB, WS_KPE = 434 * MiB, WS_LSE = 436 * MiB, WS_GATES = 437 * MiB, WS_QB = 565 * MiB;
constexpr size_t WS_MERGED = 565 * MiB;
constexpr size_t WS_G = 82 * MiB, WS_U = 258 * MiB;
constexpr size_t WS_END = 661 * MiB;
namespace pg8 {
#define PG8_LAS __attribute__((address_space(3)))
typedef unsigned short bf16_t;
typedef short bf16x8 __attribute__((ext_vector_type(8)));
typedef float f32x4 __attribute__((ext_vector_type(4)));
typedef unsigned u32x4 __attribute__((ext_vector_type(4)));
constexpr int BM = 256, BK = 64, HALF = 128, HTB = HALF * BK * 2  , STAGE_BYTES = 8 * HTB, NXCD = 8, WGM = 4;

__host__ __device__ __forceinline__ int lds_byte(int r, int c) { const int st = (r >> 4) * 2 + (c >> 5), rr = r & 15, cc = c & 31, ob = rr * 64 + cc * 2; return st * 1024 + (ob ^ (((ob >> 9) & 1) << 5)); }
__host__ __device__ __forceinline__ void stage_rc(int b, int& R, int& C) { const int st = b / 1024, sb = b % 1024, swz = sb ^ (((sb >> 9) & 1) << 5); R = (st >> 1) * 16 + swz / 64; C = (st & 1) * 32 + (swz % 64) / 2; }
__host__ __device__ __forceinline__ int perm32(int rho) { const int n = rho >> 4, i = rho & 15; return 8 * (i >> 2) + 4 * n + (i & 3); }

struct Unit { int pm, pn; };
struct Gemm { const bf16_t* A; const bf16_t* Bt; int M, N, K; };

struct StaticOrder {
    int nM, nN, nwg, G, c;
    __host__ __device__ void init(int M, int N, int G_, int c_) { nM = M / BM; nN = N / BM; nwg = nM * nN; G = G_; c = c_; }
    __host__ __device__ bool next(int i, Unit& u) const {
        const long L = (long)i * G + c; if (L >= nwg) return false;
        int wgid = (int)L; { const int q = nwg / NXCD, r = nwg % NXCD, xcd = wgid % NXCD, off = wgid / NXCD; wgid = (xcd < r ? xcd * (q + 1) : r * (q + 1) + (xcd - r) * q) + off; }
        const int nig = WGM * nN, gid = wgid / nig, fm = gid * WGM, gsz = (nM - fm) < WGM ? (nM - fm) : WGM;
        u.pm = fm + ((wgid % nig) % gsz); u.pn = (wgid % nig) / gsz; return true;
    }
    __device__ __forceinline__ void a_ready(const Unit&) const {}
    __device__ __forceinline__ void done(const Unit&) const {}
};
__device__ __forceinline__ unsigned cvt_pk_bf16(float lo, float hi) { unsigned r; asm volatile("v_cvt_pk_bf16_f32 %0, %1, %2" : "=v"(r) : "v"(lo), "v"(hi)); return r; }
typedef float f32x2 __attribute__((ext_vector_type(2)));
typedef float f32x2 __attribute__((ext_vector_type(2)));
enum { EP_IN = 0, EP_CQ, EP_CKV, EP_YA, EP_YB, EP_RES, EP_U };
struct EpiP { unsigned char* ws; const float* f0; float* fo; };
#define EGAS __attribute__((address_space(1)))
#define WSB(off) ((EGAS bf16_t*)(p.ws + (off)))
#define WSF(off) ((const EGAS float*)(p.ws + (off)))
__device__ __forceinline__ void st8(EGAS bf16_t* dst, f32x4 v0, f32x4 v1) {
    u32x4 w; w.x = cvt_pk_bf16(v0[0], v0[1]); w.y = cvt_pk_bf16(v0[2], v0[3]); w.z = cvt_pk_bf16(v1[0], v1[1]); w.w = cvt_pk_bf16(v1[2], v1[3]); *(EGAS u32x4*)dst = w; }
typedef unsigned u32x2e __attribute__((ext_vector_type(2)));
__device__ __forceinline__ void st8f8(EGAS unsigned char* dst, f32x4 v0, f32x4 v1) {
    int w0 = __builtin_amdgcn_cvt_pk_fp8_f32(v0[0], v0[1], 0, false); w0 = __builtin_amdgcn_cvt_pk_fp8_f32(v0[2], v0[3], w0, true);
    int w1 = __builtin_amdgcn_cvt_pk_fp8_f32(v1[0], v1[1], 0, false); w1 = __builtin_amdgcn_cvt_pk_fp8_f32(v1[2], v1[3], w1, true);
    *(EGAS u32x2e*)dst = (u32x2e){(unsigned)w0, (unsigned)w1}; }
#define WS8(off) ((EGAS unsigned char*)(p.ws + (off)))
__device__ __forceinline__ void ld8f8(const EGAS unsigned char* src, f32x4& v0, f32x4& v1) {
    typedef float f32x2g __attribute__((ext_vector_type(2)));
    const u32x2e w = *(const EGAS u32x2e*)src;
    const f32x2g a = __builtin_amdgcn_cvt_pk_f32_fp8((int)w.x, false), b = __builtin_amdgcn_cvt_pk_f32_fp8((int)w.x, true), c = __builtin_amdgcn_cvt_pk_f32_fp8((int)w.y, false), d = __builtin_amdgcn_cvt_pk_f32_fp8((int)w.y, true);
    v0 = (f32x4){a.x, a.y, b.x, b.y}; v1 = (f32x4){c.x, c.y, d.x, d.y}; }
__device__ __forceinline__ void ld8(const EGAS bf16_t* src, f32x4& v0, f32x4& v1) {
    const u32x4 w = *(const EGAS u32x4*)src;
    v0[0] = __uint_as_float(w.x << 16); v0[1] = __uint_as_float(w.x & 0xffff0000u); v0[2] = __uint_as_float(w.y << 16); v0[3] = __uint_as_float(w.y & 0xffff0000u);
    v1[0] = __uint_as_float(w.z << 16); v1[1] = __uint_as_float(w.z & 0xffff0000u); v1[2] = __uint_as_float(w.w << 16); v1[3] = __uint_as_float(w.w & 0xffff0000u); }
__device__ __forceinline__ void rope8(f32x4& v0, f32x4& v1, const EGAS float* tab) {
    const f32x4 c0 = *(const EGAS f32x4*)tab, c1 = *(const EGAS f32x4*)(tab + 4);
    f32x4 a, b;
    a[0] = v0[0] * c0[0] - v0[1] * c0[1]; a[1] = v0[1] * c0[0] + v0[0] * c0[1]; a[2] = v0[2] * c0[2] - v0[3] * c0[3]; a[3] = v0[3] * c0[2] + v0[2] * c0[3];
    b[0] = v1[0] * c1[0] - v1[1] * c1[1]; b[1] = v1[1] * c1[0] + v1[0] * c1[1]; b[2] = v1[2] * c1[2] - v1[3] * c1[3]; b[3] = v1[3] * c1[2] + v1[2] * c1[3];
    v0 = a; v1 = b; }
__device__ __forceinline__ float sigm(float x) { return __builtin_amdgcn_rcpf(1.f + __expf(-x)); }
template <int MODE> struct Epi {
    static constexpr bool PERM = true, AFTER_DRAIN = false;
    EpiP p;
    __device__ __forceinline__ void operator()(const f32x4 (&acc)[2][2][4][2], const Unit& u, int wr, int wc, int fr, int fq) const {
        const int row0 = u.pm * BM + wr * 64 + fr, pn = u.pn, cw = wc * 32 + 8 * fq;
        float rs[2][4];
#pragma unroll
        for (int ai = 0; ai < 2; ++ai)
#pragma unroll
            for (int m = 0; m < 4; ++m) rs[ai][m] = 1.f;
        if constexpr (MODE == EP_IN || MODE == EP_U) {
            const EGAS float* rsp = WSF(WS_RSTD) + row0;
#pragma unroll
            for (int ai = 0; ai < 2; ++ai)
#pragma unroll
                for (int m = 0; m < 4; ++m) rs[ai][m] = rsp[ai * HALF + m * 16];
        }
#pragma unroll
        for (int ai = 0; ai < 2; ++ai)
#pragma unroll
            for (int m = 0; m < 4; ++m) {
                const unsigned row = (unsigned)(row0 + ai * HALF + m * 16);
#pragma unroll
                for (int bj = 0; bj < 2; ++bj) {
                    f32x4 v0 = acc[ai][bj][m][0], v1 = acc[ai][bj][m][1];
                    if constexpr (MODE == EP_IN || MODE == EP_U) { v0 = v0 * rs[ai][m]; v1 = v1 * rs[ai][m]; }
                    const int ct = bj * HALF + cw;
                    if constexpr (MODE == EP_IN) {
                        if (pn < 12) {
                            rope8(v0, v1, WSF(WS_ROPEA) + (row * 64 + (cw >> 1)) * 2);
                            EGAS bf16_t* O = pn < 6 ? WSB(WS_QA) : WSB(WS_KA); const int c = (pn < 6 ? pn : pn - 6) * 256 + ct;
                            st8(O + row * WA + c, v0, v1);
                        } else if (pn < 18) { st8(WSB(WS_VA) + row * WA + (pn - 12) * 256 + ct, v0, v1);
                        } else if (pn < 20) { st8(WSB(WS_QL) + row * QLORA + (pn - 18) * 256 + ct, v0, v1);
                        } else if (pn < 22) { st8(WSB(WS_KVL) + row * KVLORA + (pn - 20) * 256 + ct, v0, v1);
                        } else if (pn < 38) {
                            const int gc = (pn - 22) * 256 + ct; const EGAS float* bg = (const EGAS float*)p.f0; const f32x4 b0 = *(const EGAS f32x4*)(bg + gc), b1 = *(const EGAS f32x4*)(bg + gc + 4);
#pragma unroll
                            for (int e = 0; e < 4; ++e) { v0[e] = sigm(v0[e] + b0[e]); v1[e] = sigm(v1[e] + b1[e]); }
                            st8f8(WS8(WS_GATES) + row * 4096 + gc, v0, v1);
                        } else {
                            if (bj == 0 && wc < 2) { rope8(v0, v1, WSF(WS_ROPEB) + (row * 32 + (cw >> 1)) * 2); st8f8(WS8(WS_KPE) + row * 64 + cw, v0, v1); }
                        }
                    } else if constexpr (MODE == EP_CQ) {
                        constexpr float QS = 8.f * 0.07216878364870323f * 1.4426950408889634f;
                        if (pn < 8) { st8f8(WS8(WS_QB) + row * 3072 + (pn * 2 + bj) * 192 + cw, v0 * QS, v1 * QS); }
                        else { const int head = (pn - 8) * 4 + bj * 2 + (wc >> 1), loc = (wc & 1) * 32 + 8 * fq;
                            rope8(v0, v1, WSF(WS_ROPEB) + (row * 32 + (loc >> 1)) * 2); st8f8(WS8(WS_QB) + row * 3072 + head * 192 + 128 + loc, v0 * QS, v1 * QS); }
                    } else if constexpr (MODE == EP_CKV) {
                        if (bj == 0) st8f8(WS8(WS_KN) + row * 2048 + pn * 128 + cw, v0, v1);
                        else {
                            const unsigned t = row >> 6, k5 = row & 31u, pos = ((k5 >> 2) & 1u) * 32u + ((row >> 5) & 1u) * 16u + ((k5 & 3u) | ((k5 >> 3) << 2));
                            EGAS unsigned char* vt = WS8(WS_VB) + ((size_t)(pn * (S_ / 64) + t) * 128 + cw) * 64 + pos;
                            const int w0 = __builtin_amdgcn_cvt_pk_fp8_f32(v0[0], v0[1], 0, false), w1 = __builtin_amdgcn_cvt_pk_fp8_f32(v0[2], v0[3], 0, false);
                            const int w2 = __builtin_amdgcn_cvt_pk_fp8_f32(v1[0], v1[1], 0, false), w3 = __builtin_amdgcn_cvt_pk_fp8_f32(v1[2], v1[3], 0, false);
                            vt[0] = (unsigned char)w0; vt[64] = (unsigned char)(w0 >> 8); vt[128] = (unsigned char)w1; vt[192] = (unsigned char)(w1 >> 8);
                            vt[256] = (unsigned char)w2; vt[320] = (unsigned char)(w2 >> 8); vt[384] = (unsigned char)w3; vt[448] = (unsigned char)(w3 >> 8); }
                    } else if constexpr (MODE == EP_YA) {
                        const int c = pn * 256 + ct; f32x4 g0, g1; ld8f8(WS8(WS_GATES) + row * 4096 + c, g0, g1);
                        st8(WSB(WS_T) + row * 2048 + c, v0 * g0, v1 * g1);
                    } else if constexpr (MODE == EP_YB) {
                        const int c = pn * 256 + ct; f32x4 g0, g1, t0, t1; ld8f8(WS8(WS_GATES) + row * 4096 + 2048 + c, g0, g1); ld8(WSB(WS_T) + row * 2048 + c, t0, t1);
                        st8(WSB(WS_MERGED) + row * 2048 + c, t0 + v0 * g0, t1 + v1 * g1);
                    } else if constexpr (MODE == EP_RES) {
                        const int c = pn * 256 + ct; EGAS bf16_t* xb = (EGAS bf16_t*)((EGAS unsigned char*)p.fo + 67108864) + row * 2048 + c; f32x4 x0, x1;
                        if (p.f0) { const EGAS float* xi = (const EGAS float*)p.f0 + row * 2048 + c; x0 = *(const EGAS f32x4*)xi; x1 = *(const EGAS f32x4*)(xi + 4); } else ld8(xb, x0, x1);
                        st8(xb, x0 + v0, x1 + v1);
                    } else {
                        st8(WSB(WS_U) + row * 11264 + pn * 256 + ct, v0, v1);
                    }
                }
            }
    }
};
template <class Epi, class Sched, bool ALIGN_EPI = false, bool SP2 = false>
__device__ __forceinline__ void gemm_phase(PG8_LAS unsigned char* lds, const Gemm g, const Sched& S, const Epi& E) {
    int tid_ = threadIdx.x; asm volatile("" : "+v"(tid_));
    const int tid = tid_, wid = __builtin_amdgcn_readfirstlane(tid >> 6), lane = tid & 63, wr = wid >> 2, wc = wid & 3, fr = lane & 15, fq = lane >> 4;
    const int K = g.K, nt = K / BK;
    unsigned voffA[2], voffB[2];
#pragma unroll
    for (int i = 0; i < 2; ++i) { int R, C; stage_rc(tid * 16 + i * 8192, R, C); const int Rb = Epi::PERM ? ((R & ~31) + perm32(R & 31)) : R;
        voffA[i] = (unsigned)(R * K + C) * 2u; voffB[i] = (unsigned)(Rb * K + C) * 2u; }
    const size_t kstep = (size_t)(BK * 2);
    const size_t hstep = (size_t)HALF * K * 2;
    const size_t tstep = 2 * hstep;
    const unsigned ldsw = (unsigned)wid * 1024u;
    const int aoff = lds_byte(wr * 64 + fr, fq * 8), boff = lds_byte(wc * 32 + fr, fq * 8);
#define PG8_SA(b, h) (((b) * 2 + (h)) * HTB)
#define PG8_SB(b, h) ((4 + (b) * 2 + (h)) * HTB)
#define PG8_STAGE(bufoff, gbase, voff) do { _Pragma("unroll") for (int _i = 0; _i < 2; ++_i) \
        __builtin_amdgcn_global_load_lds((const unsigned*)((const char*)(gbase) + (voff)[_i]), (PG8_LAS unsigned*)(lds + (bufoff) + ldsw + _i * 8192), 16, 0, 0); } while (0)
#define PG8_LDA(dst, b, h) do { _Pragma("unroll") for (int m = 0; m < 4; ++m) _Pragma("unroll") for (int k = 0; k < 2; ++k) dst[m][k] = *(const PG8_LAS bf16x8*)(lds + PG8_SA(b, h) + aoff + m * 2048 + k * 1024); } while (0)
#define PG8_LDB(dst, b, h) do { _Pragma("unroll") for (int n = 0; n < 2; ++n) _Pragma("unroll") for (int k = 0; k < 2; ++k) dst[n][k] = *(const PG8_LAS bf16x8*)(lds + PG8_SB(b, h) + boff + n * 2048 + k * 1024); } while (0)
#define PG8_MMA(ai, bj, At, Bt) do { __builtin_amdgcn_s_setprio(1); _Pragma("unroll") for (int m = 0; m < 4; ++m) _Pragma("unroll") for (int n = 0; n < 2; ++n) _Pragma("unroll") for (int k = 0; k < 2; ++k) \
        acc[ai][bj][m][n] = __builtin_amdgcn_mfma_f32_16x16x32_bf16(Bt[n][k], At[m][k], acc[ai][bj][m][n], 0, 0, 0); __builtin_amdgcn_s_setprio(0); } while (0)
#define PG8_WAIT_V(n) asm volatile("s_waitcnt vmcnt(" #n ")" ::: "memory")
#define PG8_WAIT_L(n) asm volatile("s_waitcnt lgkmcnt(" #n ")" ::: "memory")
#define PG8_BAR __builtin_amdgcn_s_barrier()
#define PG8_SCHED __builtin_amdgcn_sched_barrier(0)
    Unit cur, nxt; int ui = 0;
    if (!S.next(0, cur)) return;
    f32x4 acc[2][2][4][2];
#pragma unroll
    for (int a = 0; a < 2; ++a)
#pragma unroll
        for (int b = 0; b < 2; ++b)
#pragma unroll
            for (int m = 0; m < 4; ++m)
#pragma unroll
                for (int n = 0; n < 2; ++n) acc[a][b][m][n] = (f32x4){0.f, 0.f, 0.f, 0.f};
    bf16x8 At[4][2], B0[2][2], B1[2][2];
    const char* cA = (const char*)g.A + (size_t)cur.pm * tstep; const char* cB = (const char*)g.Bt + (size_t)cur.pn * tstep;
    S.a_ready(cur);
    if constexpr (SP2) {
        PG8_STAGE(PG8_SB(0, 0), cB, voffB); PG8_STAGE(PG8_SB(0, 1), cB + hstep, voffB); PG8_STAGE(PG8_SA(0, 0), cA, voffA); PG8_STAGE(PG8_SA(0, 1), cA + hstep, voffA);
        if (wr == 1) PG8_BAR;
        PG8_WAIT_V(2); PG8_BAR;
        PG8_STAGE(PG8_SB(1, 0), cB + kstep, voffB); PG8_STAGE(PG8_SA(1, 0), cA + kstep, voffA); PG8_STAGE(PG8_SB(1, 1), cB + hstep + kstep, voffB);
        PG8_WAIT_V(6); PG8_BAR;
    } else {
        PG8_STAGE(PG8_SB(0, 0), cB, voffB); PG8_STAGE(PG8_SA(0, 0), cA, voffA); PG8_STAGE(PG8_SB(0, 1), cB + hstep, voffB); PG8_STAGE(PG8_SA(0, 1), cA + hstep, voffA);
        if (wr == 1) PG8_BAR;
        PG8_WAIT_V(4); PG8_BAR;
        PG8_STAGE(PG8_SB(1, 0), cB + kstep, voffB); PG8_STAGE(PG8_SA(1, 0), cA + kstep, voffA); PG8_STAGE(PG8_SB(1, 1), cB + hstep + kstep, voffB);
        PG8_WAIT_V(6); PG8_BAR;
    }
    for (;;) {
        const bool has_next = S.next(ui + 1, nxt);
        const char* nA = has_next ? (const char*)g.A + (size_t)nxt.pm * tstep : cA; const char* nB = has_next ? (const char*)g.Bt + (size_t)nxt.pn * tstep : cB;
        for (int t = 0; t < nt; t += 2) {
            const bool last = (t == nt - 2);
            const char* a1 = cA + (size_t)(t + 1) * kstep;
            const char* a2 = last ? nA : cA + (size_t)(t + 2) * kstep; const char* b2 = last ? nB : cB + (size_t)(t + 2) * kstep;
            const char* a3 = a2 + kstep; const char* b3 = b2 + kstep;
            if (last && has_next) S.a_ready(nxt);
            if constexpr (SP2) {
            PG8_LDB(B0, 0, 0); PG8_LDB(B1, 0, 1); PG8_SCHED; PG8_LDA(At, 0, 0); PG8_STAGE(PG8_SA(1, 1), a1 + hstep, voffA);
            PG8_WAIT_V(8); PG8_WAIT_L(0); PG8_BAR; PG8_MMA(0, 0, At, B0); PG8_MMA(0, 1, At, B1); PG8_BAR; PG8_SCHED;
            PG8_LDA(At, 0, 1); PG8_STAGE(PG8_SB(0, 0), b2, voffB); PG8_STAGE(PG8_SB(0, 1), b2 + hstep, voffB); PG8_STAGE(PG8_SA(0, 0), a2, voffA);
            PG8_WAIT_V(8); PG8_WAIT_L(0); PG8_BAR; PG8_MMA(1, 0, At, B0); PG8_MMA(1, 1, At, B1); PG8_BAR; PG8_SCHED;
            PG8_LDB(B0, 1, 0); PG8_LDB(B1, 1, 1); PG8_SCHED; PG8_LDA(At, 1, 0); PG8_STAGE(PG8_SA(0, 1), a2 + hstep, voffA);
            PG8_WAIT_V(8); PG8_WAIT_L(0); PG8_BAR; PG8_MMA(0, 0, At, B0); PG8_MMA(0, 1, At, B1); PG8_BAR; PG8_SCHED;
            PG8_LDA(At, 1, 1); PG8_STAGE(PG8_SB(1, 0), b3, voffB); PG8_STAGE(PG8_SB(1, 1), b3 + hstep, voffB); PG8_STAGE(PG8_SA(1, 0), a3, voffA);
            PG8_WAIT_V(8); PG8_WAIT_L(0); PG8_BAR; PG8_MMA(1, 0, At, B0); PG8_MMA(1, 1, At, B1); PG8_BAR; PG8_SCHED;
            } else {
            PG8_LDB(B0, 0, 0); PG8_SCHED; PG8_LDA(At, 0, 0); PG8_STAGE(PG8_SA(1, 1), a1 + hstep, voffA);
            PG8_WAIT_L(8); PG8_BAR; PG8_WAIT_L(0); PG8_MMA(0, 0, At, B0); PG8_BAR; PG8_SCHED;
            PG8_LDB(B1, 0, 1); PG8_STAGE(PG8_SB(0, 0), b2, voffB);
            PG8_BAR; PG8_WAIT_L(0); PG8_MMA(0, 1, At, B1); PG8_BAR;
            PG8_LDA(At, 0, 1); PG8_STAGE(PG8_SA(0, 0), a2, voffA);
            PG8_BAR; PG8_WAIT_L(0); PG8_MMA(1, 0, At, B0); PG8_BAR; PG8_SCHED;
            PG8_STAGE(PG8_SB(0, 1), b2 + hstep, voffB);
            PG8_WAIT_V(6); PG8_BAR; PG8_MMA(1, 1, At, B1); PG8_BAR;
            PG8_LDB(B0, 1, 0); PG8_SCHED; PG8_LDA(At, 1, 0); PG8_STAGE(PG8_SA(0, 1), a2 + hstep, voffA);
            PG8_WAIT_L(8); PG8_BAR; PG8_WAIT_L(0); PG8_MMA(0, 0, At, B0); PG8_BAR; PG8_SCHED;
            PG8_LDB(B1, 1, 1); PG8_STAGE(PG8_SB(1, 0), b3, voffB);
            PG8_BAR; PG8_WAIT_L(0); PG8_MMA(0, 1, At, B1); PG8_BAR;
            PG8_LDA(At, 1, 1); PG8_STAGE(PG8_SA(1, 0), a3, voffA);
            PG8_BAR; PG8_WAIT_L(0); PG8_MMA(1, 0, At, B0); PG8_BAR; PG8_SCHED;
            PG8_STAGE(PG8_SB(1, 1), b3 + hstep, voffB);
            PG8_WAIT_V(6); PG8_BAR; PG8_MMA(1, 1, At, B1); PG8_BAR;
            }
        }
        if constexpr (ALIGN_EPI) { if (wr == 0) PG8_BAR; }
        if constexpr (!Epi::AFTER_DRAIN) { E(acc, cur, wr, wc, fr, fq); S.done(cur); }
        if (!has_next) break;
#pragma unroll
        for (int a = 0; a < 2; ++a)
#pragma unroll
            for (int b = 0; b < 2; ++b)
#pragma unroll
                for (int m = 0; m < 4; ++m)
#pragma unroll
                    for (int n = 0; n < 2; ++n) acc[a][b][m][n] = (f32x4){0.f, 0.f, 0.f, 0.f};
        cur = nxt; cA = nA; cB = nB; ++ui;
        if constexpr (ALIGN_EPI) { if (wr == 1) PG8_BAR; }
    }
    PG8_WAIT_V(0);
    if constexpr (!ALIGN_EPI) { if (wr == 0) PG8_BAR; }
    PG8_BAR;
    if constexpr (Epi::AFTER_DRAIN) { E.fused(acc, cur, wr, wc, fr, fq, lds, wid, lane); S.done(cur); }
#undef PG8_SA
#undef PG8_SB
#undef PG8_STAGE
#undef PG8_LDA
#undef PG8_LDB
#undef PG8_MMA
#undef PG8_WAIT_V
#undef PG8_WAIT_L
#undef PG8_BAR
#undef PG8_SCHED
}
}
namespace att {
typedef unsigned short bf16_t;
typedef short bf16x8 __attribute__((ext_vector_type(8)));
typedef short s16x4 __attribute__((ext_vector_type(4)));
typedef float f32x16 __attribute__((ext_vector_type(16)));
typedef unsigned u32x4 __attribute__((ext_vector_type(4)));
constexpr int SHM_V = 16384, SHM_K = 16384, SHM_KR = 8192;
constexpr int OFF_V = 0, OFF_K = 2 * SHM_V, OFF_KR = OFF_K + 2 * SHM_K, OFF_WS = OFF_KR + 2 * SHM_KR, ATT_LDS = OFF_WS + 8 * 64 * 4;
#ifndef ATT_SDEPTH
#define ATT_SDEPTH 2
#endif
constexpr int SDEPTH = ATT_SDEPTH;
#define KSWZ(row, colB) ((row) * 256 + ((colB) ^ (((row) & 15) << 4)))
#define KRSWZ(row, colB) ((row) * 128 + ((colB) ^ ((((row) >> 1) & 7) << 4)))
#define SBAR() __builtin_amdgcn_sched_barrier(0)
__device__ __forceinline__ int crow(int r, int hi) { return (r & 3) + 8 * (r >> 2) + 4 * hi; }
__device__ __forceinline__ unsigned cvtpk(float lo, float hi) { unsigned r; asm volatile("v_cvt_pk_bf16_f32 %0, %1, %2" : "=v"(r) : "v"(lo), "v"(hi)); return r; }

__device__ __forceinline__ void partialSM(f32x16& p0, f32x16& p1, float& m_reg, float& mn, float& alpha, const float C, const float thr_raw) {
  float pmax = p0[0];
#pragma unroll
  for (int r = 1; r < 16; ++r) pmax = fmaxf(pmax, p0[r]);
#pragma unroll
  for (int r = 0; r < 16; ++r) pmax = fmaxf(pmax, p1[r]);
  { auto rr = __builtin_amdgcn_permlane32_swap(__float_as_uint(pmax), __float_as_uint(pmax), false, false);
    pmax = fmaxf(__uint_as_float(rr[0]), __uint_as_float(rr[1])); }
  if (__builtin_expect(__all(pmax - m_reg <= thr_raw), 1)) { mn = m_reg; alpha = 1.f; }
  else { mn = fmaxf(m_reg, pmax); alpha = __builtin_amdgcn_exp2f((m_reg - mn) * C); m_reg = mn; }
  const float mnC = -mn * C;
#pragma unroll
  for (int r = 0; r < 16; ++r) p0[r] = fmaf(p0[r], C, mnC);
#pragma unroll
  for (int r = 0; r < 16; ++r) p1[r] = fmaf(p1[r], C, mnC);
#pragma unroll
  for (int r = 0; r < 16; ++r) p0[r] = __builtin_amdgcn_exp2f(p0[r]);
}
__device__ __forceinline__ void finishSM(f32x16& p0, f32x16& p1, float alpha, float& l_reg, bf16x8& pa0, bf16x8& pa1, bf16x8& pa2, bf16x8& pa3) {
#pragma unroll
  for (int r = 0; r < 16; ++r) p1[r] = __builtin_amdgcn_exp2f(p1[r]);
  float ps = 0;
#pragma unroll
  for (int r = 0; r < 16; ++r) ps += p0[r];
#pragma unroll
  for (int r = 0; r < 16; ++r) ps += p1[r];
  { auto rr = __builtin_amdgcn_permlane32_swap(__float_as_uint(ps), __float_as_uint(ps), false, false);
    ps = __uint_as_float(rr[0]) + __uint_as_float(rr[1]); }
  l_reg = l_reg * alpha + ps;
#define PK4(P, BASE, OUT) do { unsigned a0 = cvtpk(P[BASE + 0], P[BASE + 1]), a1 = cvtpk(P[BASE + 2], P[BASE + 3]);   \
    unsigned b0 = cvtpk(P[BASE + 4], P[BASE + 5]), b1 = cvtpk(P[BASE + 6], P[BASE + 7]);                              \
    auto r0 = __builtin_amdgcn_permlane32_swap(a0, b0, false, false); auto r1 = __builtin_amdgcn_permlane32_swap(a1, b1, false, false); \
    u32x4 w = {r0[0], r1[0], r0[1], r1[1]}; OUT = *reinterpret_cast<bf16x8*>(&w); } while (0)
  PK4(p0, 0, pa0); PK4(p0, 8, pa1); PK4(p1, 0, pa2); PK4(p1, 8, pa3);
#undef PK4
}
template <int NR>
__device__ __forceinline__ void qkt(f32x16& p0, f32x16& p1, const char* Ks, const char* Krs, const bf16x8* qr, int r32, int hi) {
  p0 = f32x16{}; p1 = f32x16{};
#pragma unroll
  for (int d0 = 0; d0 < 8; ++d0) { const int cb = (d0 * 16 + hi * 8) * 2;
    bf16x8 b0 = *reinterpret_cast<const bf16x8*>(Ks + KSWZ(r32, cb));
    bf16x8 b1 = *reinterpret_cast<const bf16x8*>(Ks + KSWZ(32 + r32, cb));
    p0 = __builtin_amdgcn_mfma_f32_32x32x16_bf16(b0, qr[d0], p0, 0, 0, 0);
    p1 = __builtin_amdgcn_mfma_f32_32x32x16_bf16(b1, qr[d0], p1, 0, 0, 0); if ((d0 & 3) == 3) SBAR(); }
#pragma unroll
  for (int d0 = 0; d0 < NR; ++d0) { const int cb = (d0 * 16 + hi * 8) * 2;
    bf16x8 b0 = *reinterpret_cast<const bf16x8*>(Krs + KRSWZ(r32, cb));
    bf16x8 b1 = *reinterpret_cast<const bf16x8*>(Krs + KRSWZ(32 + r32, cb));
    p0 = __builtin_amdgcn_mfma_f32_32x32x16_bf16(b0, qr[8 + d0], p0, 0, 0, 0);
    p1 = __builtin_amdgcn_mfma_f32_32x32x16_bf16(b1, qr[8 + d0], p1, 0, 0, 0); }
}
__device__ __forceinline__ void qkt_r(f32x16& p0, f32x16& p1, const char* Ks, const char* Krs, const bf16x8* qr, const char* qrl, int r32, int hi) {
  p0 = f32x16{}; p1 = f32x16{};
#pragma unroll
  for (int d0 = 0; d0 < 8; ++d0) { const int cb = (d0 * 16 + hi * 8) * 2;
    bf16x8 b0 = *reinterpret_cast<const bf16x8*>(Ks + KSWZ(r32, cb));
    bf16x8 b1 = *reinterpret_cast<const bf16x8*>(Ks + KSWZ(32 + r32, cb));
    p0 = __builtin_amdgcn_mfma_f32_32x32x16_bf16(b0, qr[d0], p0, 0, 0, 0);
    p1 = __builtin_amdgcn_mfma_f32_32x32x16_bf16(b1, qr[d0], p1, 0, 0, 0); }
#pragma unroll
  for (int d0 = 0; d0 < 4; ++d0) { const int cb = (d0 * 16 + hi * 8) * 2;
    bf16x8 b0 = *reinterpret_cast<const bf16x8*>(Krs + KRSWZ(r32, cb));
    bf16x8 b1 = *reinterpret_cast<const bf16x8*>(Krs + KRSWZ(32 + r32, cb));
    const bf16x8 q = *reinterpret_cast<const bf16x8*>(qrl + d0 * 1024);
    p0 = __builtin_amdgcn_mfma_f32_32x32x16_bf16(b0, q, p0, 0, 0, 0);
    p1 = __builtin_amdgcn_mfma_f32_32x32x16_bf16(b1, q, p1, 0, 0, 0); }
}
__device__ __forceinline__ void amask(f32x16& p0, f32x16& p1, int base) {
#pragma unroll
  for (int r = 0; r < 16; ++r) { const int d = base + (r & 3) + 8 * (r >> 2);
    if (d > 64 || d < -64) p0[r] = -30000.f;
    if (d + 32 > 64 || d + 32 < -64) p1[r] = -30000.f; }
}
__device__ __forceinline__ int v_st(int k, int c) { const int kk = (k & ~0xC) | ((k & 4) << 1) | ((k & 8) >> 1); return ((kk >> 3) * 4 + (c >> 5)) * 512 + ((kk & 7) * 32 + (c & 31)) * 2; }
__device__ __forceinline__ int v_rd_base(int lane) { return ((lane & 3) << 3) | (((lane >> 2) & 3) << 6) | (((lane >> 4) & 1) << 5) | (((lane >> 5) & 1) << 8); }
constexpr int v_rd_off(int d0, int ks, int half) { return d0 * 512 + ks * 4096 + half * 2048; }
template <int OFF> __device__ __forceinline__ s16x4 tr_read(int vb) {
  s16x4 r; asm volatile("ds_read_b64_tr_b16 %0, %1 offset:%2" : "=&v"(r) : "v"(vb), "i"(OFF) : "memory"); return r;
}
template <int D0> __device__ __forceinline__ void pv_one(f32x16& od, int vb, bf16x8 pa0, bf16x8 pa1, bf16x8 pa2, bf16x8 pa3) {
  const s16x4 l0 = tr_read<v_rd_off(D0, 0, 0)>(vb), h0 = tr_read<v_rd_off(D0, 0, 1)>(vb), l1 = tr_read<v_rd_off(D0, 1, 0)>(vb), h1 = tr_read<v_rd_off(D0, 1, 1)>(vb);
  const s16x4 l2 = tr_read<v_rd_off(D0, 2, 0)>(vb), h2 = tr_read<v_rd_off(D0, 2, 1)>(vb), l3 = tr_read<v_rd_off(D0, 3, 0)>(vb), h3 = tr_read<v_rd_off(D0, 3, 1)>(vb);
  asm volatile("s_waitcnt lgkmcnt(0)" ::: "memory"); SBAR();
#define PK(L, H) (bf16x8){L[0], L[1], L[2], L[3], H[0], H[1], H[2], H[3]}
  od = __builtin_amdgcn_mfma_f32_32x32x16_bf16(pa0, PK(l0, h0), od, 0, 0, 0);
  od = __builtin_amdgcn_mfma_f32_32x32x16_bf16(pa1, PK(l1, h1), od, 0, 0, 0);
  od = __builtin_amdgcn_mfma_f32_32x32x16_bf16(pa2, PK(l2, h2), od, 0, 0, 0);
  od = __builtin_amdgcn_mfma_f32_32x32x16_bf16(pa3, PK(l3, h3), od, 0, 0, 0);
#undef PK
}
__device__ __forceinline__ void pv_d0(f32x16* o, int vb, bf16x8 pa0, bf16x8 pa1, bf16x8 pa2, bf16x8 pa3) {
  pv_one<0>(o[0], vb, pa0, pa1, pa2, pa3); pv_one<1>(o[1], vb, pa0, pa1, pa2, pa3); pv_one<2>(o[2], vb, pa0, pa1, pa2, pa3); pv_one<3>(o[3], vb, pa0, pa1, pa2, pa3);
}
template <int NR, bool MASK>
__device__ __forceinline__ void attn_unit(const bf16_t* __restrict__ Qb, int ldq, const bf16_t* __restrict__ Kh, int ldk, const bf16_t* __restrict__ Krh,
                                          const bf16_t* __restrict__ Vh, int ldv, bf16_t* __restrict__ Ob, int ldo, float* __restrict__ lse, int ldlse,
                                          const int NT, const int qoff, const float C, const float thr_raw, const float scale, char* lds) {
  int tid_ = threadIdx.x; asm volatile("" : "+v"(tid_));
  const int tid = tid_, wid = __builtin_amdgcn_readfirstlane(tid >> 6), lane = tid & 63, r32 = lane & 31, hi = lane >> 5;
  char* V_lds = lds + OFF_V; char* K_lds = lds + OFF_K; char* Kr_lds = lds + OFF_KR;
  float* ws = (float*)(lds + OFF_WS) + wid * 64; float* li_l = ws; float* al_l = ws + 32;
  float m_reg = MASK ? -30000.f : -1e30f, l_reg = 0; f32x16 o[4] = {}; bf16x8 qr[8 + NR];
  { const bf16_t* Qw = Qb + (unsigned)((wid * 32 + r32) * ldq + hi * 8);
#pragma unroll
    for (int d0 = 0; d0 < 8 + NR; ++d0) qr[d0] = *reinterpret_cast<const bf16x8*>(Qw + d0 * 16); }
  const int sr = tid >> 4, sc = (tid & 15) * 8, vst0 = v_st(sr, sc), vst1 = v_st(32 + sr, sc);
  const int krr = tid >> 3, krc = tid & 7, krst = KRSWZ(krr, krc * 16);
  const int vb0 = (int)(uintptr_t)V_lds + v_rd_base(lane);
  const int mbase = 4 * hi - (qoff + wid * 32 + r32);
  unsigned voff = (unsigned)(sr * ldv + sc), koff = (unsigned)(sr * ldk + sc), kroff = (unsigned)(krr * 64 + krc * 8);
  bf16x8 vs0, vs1, ks0, ks1, kr;
#define SLOAD() do { vs0 = *(const bf16x8*)(Vh + voff); vs1 = *(const bf16x8*)(Vh + voff + 32u * (unsigned)ldv); \
    ks0 = *(const bf16x8*)(Kh + koff); ks1 = *(const bf16x8*)(Kh + koff + 32u * (unsigned)ldk); \
    if constexpr (NR > 0) { kr = *(const bf16x8*)(Krh + kroff); kroff += 64u * 64u; } voff += 64u * (unsigned)ldv; koff += 64u * (unsigned)ldk; } while (0)
#define SWRITE(b) do { *(bf16x8*)(V_lds + (b) * SHM_V + vst0) = vs0; *(bf16x8*)(V_lds + (b) * SHM_V + vst1) = vs1; const int kc = sc * 2;  \
    *(bf16x8*)(K_lds + (b) * SHM_K + KSWZ(sr, kc)) = ks0; *(bf16x8*)(K_lds + (b) * SHM_K + KSWZ(32 + sr, kc)) = ks1; \
    if constexpr (NR > 0) *(bf16x8*)(Kr_lds + (b) * SHM_KR + krst) = kr; } while (0)
  f32x16 p0, p1; float mn, al; bf16x8 pa0, pa1, pa2, pa3;
  SLOAD(); SWRITE(0); __syncthreads();
  for (int j = 0; j < NT; ++j) {
    const int b = j & 1;
    if (j + 1 < NT) SLOAD();
    SBAR();
    bool live = true;
    if constexpr (MASK) { const int qlo = qoff + wid * 32, klo = 64 * j; live = !(klo > qlo + 31 + 64 || klo + 63 < qlo - 64); }
    if (live) {
    qkt<NR>(p0, p1, K_lds + b * SHM_K, Kr_lds + b * SHM_KR, qr, r32, hi);
    if constexpr (MASK) amask(p0, p1, 64 * j + mbase);
    partialSM(p0, p1, m_reg, mn, al, C, thr_raw);
    if (__any(al < 1.f)) { if (hi == 0) al_l[r32] = al; asm volatile("s_waitcnt lgkmcnt(0)" ::: "memory");
#pragma unroll
      for (int d = 0; d < 4; ++d)
#pragma unroll
        for (int r = 0; r < 16; ++r) o[d][r] *= al_l[crow(r, hi)]; }
    finishSM(p0, p1, al, l_reg, pa0, pa1, pa2, pa3); SBAR();
    pv_d0(o, vb0 + b * SHM_V, pa0, pa1, pa2, pa3);
    }
    SBAR();
    if (j + 1 < NT) SWRITE(b ^ 1);
    __syncthreads();
  }
  if (hi == 0) li_l[r32] = l_reg; asm volatile("s_waitcnt lgkmcnt(0)" ::: "memory");
  bf16_t* Ow = Ob + (unsigned)(wid * 32 * ldo + r32);
#pragma unroll
  for (int r = 0; r < 16; ++r) { const int orow = crow(r, hi); const float rl = __builtin_amdgcn_rcpf(li_l[orow]);
#pragma unroll
    for (int d0 = 0; d0 < 4; ++d0) Ow[(unsigned)(orow * ldo + d0 * 32)] = (bf16_t)(cvtpk(o[d0][r] * rl, 0.f) & 0xffffu); }
  if constexpr (MASK) { if (hi == 0) lse[(unsigned)((wid * 32 + r32) * ldlse)] = m_reg * scale + __logf(l_reg); }
  __syncthreads();
#undef SLOAD
#undef SWRITE
}

__device__ __forceinline__ void fakeSM(f32x16& p0, f32x16& p1, bf16x8& pa0, bf16x8& pa1, bf16x8& pa2, bf16x8& pa3) {
#define PK4(P, BASE, OUT) do { unsigned a0 = cvtpk(P[BASE + 0], P[BASE + 1]), a1 = cvtpk(P[BASE + 2], P[BASE + 3]);   \
    unsigned b0 = cvtpk(P[BASE + 4], P[BASE + 5]), b1 = cvtpk(P[BASE + 6], P[BASE + 7]);                              \
    auto r0 = __builtin_amdgcn_permlane32_swap(a0, b0, false, false); auto r1 = __builtin_amdgcn_permlane32_swap(a1, b1, false, false); \
    u32x4 w = {r0[0], r1[0], r0[1], r1[1]}; OUT = *reinterpret_cast<bf16x8*>(&w); } while (0)
  PK4(p0, 0, pa0); PK4(p0, 8, pa1); PK4(p1, 0, pa2); PK4(p1, 8, pa3);
#undef PK4
}
__device__ __forceinline__ void qkt_fake(f32x16& p0, f32x16& p1, const bf16x8* qr) {
  p0 = f32x16{}; p1 = f32x16{};
#pragma unroll
  for (int d0 = 0; d0 < 12; ++d0) { p0 = __builtin_amdgcn_mfma_f32_32x32x16_bf16(qr[(d0 + 1) & 7], qr[d0 & 7], p0, 0, 0, 0); p1 = __builtin_amdgcn_mfma_f32_32x32x16_bf16(qr[(d0 + 2) & 7], qr[d0 & 7], p1, 0, 0, 0); }
}
__device__ __forceinline__ void pv_fake(f32x16* o, bf16x8 pa0, bf16x8 pa1, bf16x8 pa2, bf16x8 pa3) {
#pragma unroll
  for (int d = 0; d < 4; ++d) { o[d] = __builtin_amdgcn_mfma_f32_32x32x16_bf16(pa0, pa1, o[d], 0, 0, 0); o[d] = __builtin_amdgcn_mfma_f32_32x32x16_bf16(pa1, pa2, o[d], 0, 0, 0);
    o[d] = __builtin_amdgcn_mfma_f32_32x32x16_bf16(pa2, pa3, o[d], 0, 0, 0); o[d] = __builtin_amdgcn_mfma_f32_32x32x16_bf16(pa3, pa0, o[d], 0, 0, 0); }
}
template <int NR, int FAKE = 0>
__device__ __forceinline__ void attn_unit2(const bf16_t* __restrict__ Qb, int ldq, const bf16_t* __restrict__ Kh, int ldk, const bf16_t* __restrict__ Krh,
                                           const bf16_t* __restrict__ Vh, int ldv, bf16_t* __restrict__ Ob, int ldo, const int NT, const float C, const float thr_raw, char* lds) {
  int tid_ = threadIdx.x; asm volatile("" : "+v"(tid_));
  const int tid = tid_, wid = tid >> 6, lane = tid & 63, r32 = lane & 31, hi = lane >> 5;
  char* V_lds = lds + OFF_V; char* K_lds = lds + OFF_K; char* Kr_lds = lds + OFF_KR;
  float* ws = (float*)(lds + OFF_WS) + wid * 64; float* li_l = ws; float* al_l = ws + 32;
  float m_reg = -1e30f, l_reg = 0; f32x16 o[4] = {}; bf16x8 qr[8];
  char* qrl = lds + ATT_LDS + wid * 4096 + lane * 16;
  { const bf16_t* Qw = Qb + (unsigned)((wid * 32 + r32) * ldq + hi * 8);
#pragma unroll
    for (int d0 = 0; d0 < 8; ++d0) qr[d0] = *reinterpret_cast<const bf16x8*>(Qw + d0 * 16);
#pragma unroll
    for (int d0 = 0; d0 < 4; ++d0) *reinterpret_cast<bf16x8*>(qrl + d0 * 1024) = *reinterpret_cast<const bf16x8*>(Qw + (8 + d0) * 16); }
  const int sr = tid >> 4, sc = (tid & 15) * 8, vst0 = v_st(sr, sc), kst0 = KSWZ(sr, sc * 2);
  const int krr = tid >> 3, krc = tid & 7, krst = KRSWZ(krr, krc * 16);
  const int vb0 = (int)(uintptr_t)V_lds + v_rd_base(lane);
  unsigned voff = (unsigned)(sr * ldv + sc), kroff = (unsigned)(krr * 64 + krc * 8);
  bf16x8 vs0, vs1, ks0, ks1, kr;
#define SLOAD() do { vs0 = *(const bf16x8*)(Vh + voff); vs1 = *(const bf16x8*)(Vh + voff + 32u * (unsigned)ldv); \
    ks0 = *(const bf16x8*)(Kh + voff); ks1 = *(const bf16x8*)(Kh + voff + 32u * (unsigned)ldv); \
    if constexpr (NR > 0) { kr = *(const bf16x8*)(Krh + kroff); kroff += 64u * 64u; } voff += 64u * (unsigned)ldv; } while (0)
#define SWRITE(b) do { *(bf16x8*)(V_lds + (b) * SHM_V + vst0) = vs0; *(bf16x8*)(V_lds + (b) * SHM_V + vst0 + 8192) = vs1;  \
    *(bf16x8*)(K_lds + (b) * SHM_K + kst0) = ks0; *(bf16x8*)(K_lds + (b) * SHM_K + kst0 + 8192) = ks1; \
    if constexpr (NR > 0) *(bf16x8*)(Kr_lds + (b) * SHM_KR + krst) = kr; } while (0)
#define RESC(a) do { if (__any((a) < 1.f)) { if (hi == 0) al_l[r32] = (a); asm volatile("s_waitcnt lgkmcnt(0)" ::: "memory"); \
    _Pragma("unroll") for (int d = 0; d < 4; ++d) _Pragma("unroll") for (int r = 0; r < 16; ++r) o[d][r] *= al_l[crow(r, hi)]; } } while (0)
  f32x16 pA0, pA1, pB0, pB1; float mnA, mnB, alA = 1.f, alB = 1.f; bf16x8 pa0, pa1, pa2, pa3;
#define QKT_A(K, KR) do { if constexpr (FAKE >= 2) qkt_fake(pA0, pA1, qr); else qkt_r(pA0, pA1, K, KR, qr, qrl, r32, hi); } while (0)
#define QKT_B(K, KR) do { if constexpr (FAKE >= 2) qkt_fake(pB0, pB1, qr); else qkt_r(pB0, pB1, K, KR, qr, qrl, r32, hi); } while (0)
#define PSM(P0, P1, MN, AL) do { if constexpr (FAKE == 0) partialSM(P0, P1, m_reg, MN, AL, C, thr_raw); } while (0)
#define FSM(P0, P1, AL) do { if constexpr (FAKE == 0) finishSM(P0, P1, AL, l_reg, pa0, pa1, pa2, pa3); else fakeSM(P0, P1, pa0, pa1, pa2, pa3); } while (0)
#define PVD(VB) do { if constexpr (FAKE >= 3) pv_fake(o, pa0, pa1, pa2, pa3); else pv_d0(o, VB, pa0, pa1, pa2, pa3); } while (0)
  SLOAD(); SWRITE(0); __syncthreads();
  SLOAD();
  QKT_A(K_lds, Kr_lds); PSM(pA0, pA1, mnA, alA);
  SWRITE(1); __syncthreads();
  for (int j = 1; j + 1 < NT; j += 2) {
    SLOAD(); SBAR();
    QKT_B(K_lds + SHM_K, Kr_lds + SHM_KR);
    FSM(pA0, pA1, alA); SBAR();
    PVD(vb0); PSM(pB0, pB1, mnB, alB);
    __syncthreads(); SWRITE(0);
    RESC(alB); __syncthreads();
    if (j + 2 < NT) SLOAD();
    SBAR();
    QKT_A(K_lds, Kr_lds);
    FSM(pB0, pB1, alB); SBAR();
    PVD(vb0 + SHM_V); PSM(pA0, pA1, mnA, alA);
    __syncthreads(); if (j + 2 < NT) SWRITE(1);
    RESC(alA); __syncthreads();
  }
  SBAR(); QKT_B(K_lds + SHM_K, Kr_lds + SHM_KR);
  FSM(pA0, pA1, alA); SBAR();
  PVD(vb0); PSM(pB0, pB1, mnB, alB);
  RESC(alB);
  FSM(pB0, pB1, alB); SBAR();
  PVD(vb0 + SHM_V);
  if constexpr (FAKE != 0) l_reg = 1.f;
  if (hi == 0) li_l[r32] = l_reg; asm volatile("s_waitcnt lgkmcnt(0)" ::: "memory");
  bf16_t* Ow = Ob + (unsigned)(wid * 32 * ldo + r32);
#pragma unroll
  for (int r = 0; r < 16; ++r) { const int orow = crow(r, hi); const float rl = __builtin_amdgcn_rcpf(li_l[orow]);
#pragma unroll
    for (int d0 = 0; d0 < 4; ++d0) Ow[(unsigned)(orow * ldo + d0 * 32)] = (bf16_t)(cvtpk(o[d0][r] * rl, 0.f) & 0xffffu); }
  __syncthreads();
#undef SLOAD
#undef SWRITE
#undef RESC
#undef QKT_A
#undef QKT_B
#undef PSM
#undef FSM
#undef PVD
}
typedef int v8i32 __attribute__((ext_vector_type(8)));
typedef int v4i32 __attribute__((ext_vector_type(4)));
constexpr int F8_V = 0, F8_KN = 2 * 16384, F8_KR = F8_KN + 2 * 8192, F8_WS = F8_KR + 2 * 4096, F8_LDS = F8_WS + 8 * 64 * 4;
#define KN8SW(row, chunk) ((row) * 128 + ((((chunk)) ^ (((row) >> 1) & 7)) << 4))
#define KR8SW(row, chunk) ((row) * 64 + ((((chunk)) ^ (((row) >> 2) & 3)) << 4))
__device__ __forceinline__ v8i32 cat8(v4i32 a, v4i32 b) { return (v8i32){a[0], a[1], a[2], a[3], b[0], b[1], b[2], b[3]}; }
__device__ __forceinline__ void qkt8(f32x16& p0, f32x16& p1, const char* Kn, const char* Kr, const v8i32* qf, int r32, int hi) {
  p0 = f32x16{}; p1 = f32x16{};
#pragma unroll
  for (int s = 0; s < 2; ++s) { const int c0 = s * 4 + hi * 2;
    const v8i32 a0 = cat8(*reinterpret_cast<const v4i32*>(Kn + KN8SW(r32, c0)), *reinterpret_cast<const v4i32*>(Kn + KN8SW(r32, c0 + 1)));
    const v8i32 a1 = cat8(*reinterpret_cast<const v4i32*>(Kn + 4096 + KN8SW(r32, c0)), *reinterpret_cast<const v4i32*>(Kn + 4096 + KN8SW(r32, c0 + 1)));
    p0 = __builtin_amdgcn_mfma_scale_f32_32x32x64_f8f6f4(a0, qf[s], p0, 0, 0, 0, 127, 0, 127);
    p1 = __builtin_amdgcn_mfma_scale_f32_32x32x64_f8f6f4(a1, qf[s], p1, 0, 0, 0, 127, 0, 127); }
  { const int c0 = hi * 2;
    const v8i32 a0 = cat8(*reinterpret_cast<const v4i32*>(Kr + KR8SW(r32, c0)), *reinterpret_cast<const v4i32*>(Kr + KR8SW(r32, c0 + 1)));
    const v8i32 a1 = cat8(*reinterpret_cast<const v4i32*>(Kr + 2048 + KR8SW(r32, c0)), *reinterpret_cast<const v4i32*>(Kr + 2048 + KR8SW(r32, c0 + 1)));
    p0 = __builtin_amdgcn_mfma_scale_f32_32x32x64_f8f6f4(a0, qf[2], p0, 0, 0, 0, 127, 0, 127);
    p1 = __builtin_amdgcn_mfma_scale_f32_32x32x64_f8f6f4(a1, qf[2], p1, 0, 0, 0, 127, 0, 127); }
}
__device__ __forceinline__ void attn_unit6(const unsigned char* __restrict__ Q8, int ldq, const unsigned char* __restrict__ Kn8, int ldk, const unsigned char* __restrict__ Kr8,
                                           const bf16_t* __restrict__ Vh, int ldv, bf16_t* __restrict__ Ob, int ldo, const int NT, const float C, const float thr_raw, char* lds) {
  int tid_ = threadIdx.x; asm volatile("" : "+v"(tid_));
  const int tid = tid_, wid = tid >> 6, lane = tid & 63, r32 = lane & 31, hi = lane >> 5;
  char* V_lds = lds + F8_V; char* Kn_lds = lds + F8_KN; char* Kr_lds = lds + F8_KR;
  float* ws = (float*)(lds + F8_WS) + wid * 64; float* li_l = ws; float* al_l = ws + 32;
  float m_reg = -1e30f, l_reg = 0; f32x16 o[4] = {}; v8i32 qf[3];
  { const unsigned char* Qw = Q8 + (unsigned)((wid * 32 + r32) * ldq + hi * 32);
#pragma unroll
    for (int s = 0; s < 3; ++s) qf[s] = cat8(*reinterpret_cast<const v4i32*>(Qw + s * 64), *reinterpret_cast<const v4i32*>(Qw + s * 64 + 16)); }
  const int sr = tid >> 4, sc = (tid & 15) * 8, vst0 = v_st(sr, sc);
  const int knr = tid >> 3, knc = tid & 7, knst = KN8SW(knr, knc);
  const int krr = (tid >> 2) & 63, krc = tid & 3, krst = KR8SW(krr, krc);
  const bool krw = tid < 256;
  const int vb0 = (int)(uintptr_t)V_lds + v_rd_base(lane);
  unsigned voff = (unsigned)(sr * ldv + sc), knoff = (unsigned)(knr * ldk + knc * 16), kroff = (unsigned)(krr * 64 + krc * 16);
  bf16x8 vs0, vs1; v4i32 kn, kr;
#define SLOAD() do { vs0 = *(const bf16x8*)(Vh + voff); vs1 = *(const bf16x8*)(Vh + voff + 32u * (unsigned)ldv); kn = *(const v4i32*)(Kn8 + knoff); \
    if (krw) kr = *(const v4i32*)(Kr8 + kroff); voff += 64u * (unsigned)ldv; knoff += 64u * (unsigned)ldk; kroff += 64u * 64u; } while (0)
#define SWRITE(b) do { *(bf16x8*)(V_lds + (b) * 16384 + vst0) = vs0; *(bf16x8*)(V_lds + (b) * 16384 + vst0 + 8192) = vs1;  \
    *(v4i32*)(Kn_lds + (b) * 8192 + knst) = kn; if (krw) *(v4i32*)(Kr_lds + (b) * 4096 + krst) = kr; } while (0)
#define RESC(a) do { if (__any((a) < 1.f)) { if (hi == 0) al_l[r32] = (a); asm volatile("s_waitcnt lgkmcnt(0)" ::: "memory"); \
    _Pragma("unroll") for (int d = 0; d < 4; ++d) _Pragma("unroll") for (int r = 0; r < 16; ++r) o[d][r] *= al_l[crow(r, hi)]; } } while (0)
  f32x16 pA0, pA1, pB0, pB1; float mnA, mnB, alA, alB; bf16x8 pa0, pa1, pa2, pa3;
  SLOAD(); SWRITE(0); __syncthreads();
  SLOAD();
  qkt8(pA0, pA1, Kn_lds, Kr_lds, qf, r32, hi); partialSM(pA0, pA1, m_reg, mnA, alA, C, thr_raw);
  SWRITE(1); __syncthreads();
  for (int j = 1; j + 1 < NT; j += 2) {
    SLOAD(); SBAR();
    qkt8(pB0, pB1, Kn_lds + 8192, Kr_lds + 4096, qf, r32, hi);
    finishSM(pA0, pA1, alA, l_reg, pa0, pa1, pa2, pa3); SBAR();
    pv_d0(o, vb0, pa0, pa1, pa2, pa3); partialSM(pB0, pB1, m_reg, mnB, alB, C, thr_raw);
    __syncthreads(); SWRITE(0);
    RESC(alB); __syncthreads();
    if (j + 2 < NT) SLOAD();
    SBAR();
    qkt8(pA0, pA1, Kn_lds, Kr_lds, qf, r32, hi);
    finishSM(pB0, pB1, alB, l_reg, pa0, pa1, pa2, pa3); SBAR();
    pv_d0(o, vb0 + 16384, pa0, pa1, pa2, pa3); partialSM(pA0, pA1, m_reg, mnA, alA, C, thr_raw);
    __syncthreads(); if (j + 2 < NT) SWRITE(1);
    RESC(alA); __syncthreads();
  }
  SBAR(); qkt8(pB0, pB1, Kn_lds + 8192, Kr_lds + 4096, qf, r32, hi);
  finishSM(pA0, pA1, alA, l_reg, pa0, pa1, pa2, pa3); SBAR();
  pv_d0(o, vb0, pa0, pa1, pa2, pa3); partialSM(pB0, pB1, m_reg, mnB, alB, C, thr_raw);
  RESC(alB);
  finishSM(pB0, pB1, alB, l_reg, pa0, pa1, pa2, pa3); SBAR();
  pv_d0(o, vb0 + 16384, pa0, pa1, pa2, pa3);
  if (hi == 0) li_l[r32] = l_reg; asm volatile("s_waitcnt lgkmcnt(0)" ::: "memory");
  bf16_t* Ow = Ob + (unsigned)(wid * 32 * ldo + r32);
#pragma unroll
  for (int r = 0; r < 16; ++r) { const int orow = crow(r, hi); const float rl = __builtin_amdgcn_rcpf(li_l[orow]);
#pragma unroll
    for (int d0 = 0; d0 < 4; ++d0) Ow[(unsigned)(orow * ldo + d0 * 32)] = (bf16_t)(cvtpk(o[d0][r] * rl, 0.f) & 0xffffu); }
  __syncthreads();
#undef SLOAD
#undef SWRITE
#undef RESC
}
constexpr int G8_VT = 0, G8_KN = 2 * 8192, G8_KR = G8_KN + 2 * 8192, G8_WS = G8_KR + 2 * 4096, G8_LDS = G8_WS + 8 * 64 * 4;
__device__ __forceinline__ void partialSM8(f32x16& p0, f32x16& p1, float& m_reg, float& alpha, const float C, const float thr_raw) {
  float pmax = p0[0];
#pragma unroll
  for (int r = 1; r < 16; ++r) pmax = fmaxf(pmax, p0[r]);
#pragma unroll
  for (int r = 0; r < 16; ++r) pmax = fmaxf(pmax, p1[r]);
  { auto rr = __builtin_amdgcn_permlane32_swap(__float_as_uint(pmax), __float_as_uint(pmax), false, false);
    pmax = fmaxf(__uint_as_float(rr[0]), __uint_as_float(rr[1])); }
  float mn;
  if (__builtin_expect(__all(pmax - m_reg <= thr_raw), 1)) { mn = m_reg; alpha = 1.f; }
  else { mn = fmaxf(m_reg, pmax); alpha = __builtin_amdgcn_exp2f((m_reg - mn) * C); m_reg = mn; }
  const float mnC = 7.0f - mn * C;
#pragma unroll
  for (int r = 0; r < 16; ++r) p0[r] = fmaf(p0[r], C, mnC);
#pragma unroll
  for (int r = 0; r < 16; ++r) p1[r] = fmaf(p1[r], C, mnC);
#pragma unroll
  for (int r = 0; r < 16; ++r) p0[r] = __builtin_amdgcn_exp2f(p0[r]);
}
__device__ __forceinline__ void finishSM8(f32x16& p0, f32x16& p1, float alpha, float& l_reg, v8i32& p8) {
#pragma unroll
  for (int r = 0; r < 16; ++r) p1[r] = __builtin_amdgcn_exp2f(p1[r]);
  float ps = 0;
#pragma unroll
  for (int r = 0; r < 16; ++r) ps += p0[r];
#pragma unroll
  for (int r = 0; r < 16; ++r) ps += p1[r];
  { auto rr = __builtin_amdgcn_permlane32_swap(__float_as_uint(ps), __float_as_uint(ps), false, false);
    ps = __uint_as_float(rr[0]) + __uint_as_float(rr[1]); }
  l_reg = l_reg * alpha + ps;
#pragma unroll
  for (int g = 0; g < 4; ++g) {
    int w = __builtin_amdgcn_cvt_pk_fp8_f32(p0[4 * g], p0[4 * g + 1], 0, false); p8[g] = __builtin_amdgcn_cvt_pk_fp8_f32(p0[4 * g + 2], p0[4 * g + 3], w, true);
    int u = __builtin_amdgcn_cvt_pk_fp8_f32(p1[4 * g], p1[4 * g + 1], 0, false); p8[4 + g] = __builtin_amdgcn_cvt_pk_fp8_f32(p1[4 * g + 2], p1[4 * g + 3], u, true); }
}
__device__ __forceinline__ void finishSM9(f32x16& p0, f32x16& p1, float alpha, float& l_reg, v8i32& p8) {
#pragma unroll
  for (int r = 0; r < 16; ++r) { p0[r] = __builtin_amdgcn_exp2f(p0[r]); p1[r] = __builtin_amdgcn_exp2f(p1[r]); }
  float ps = 0;
#pragma unroll
  for (int r = 0; r < 16; ++r) ps += p0[r];
#pragma unroll
  for (int r = 0; r < 16; ++r) ps += p1[r];
  { auto rr = __builtin_amdgcn_permlane32_swap(__float_as_uint(ps), __float_as_uint(ps), false, false);
    ps = __uint_as_float(rr[0]) + __uint_as_float(rr[1]); }
  l_reg = l_reg * alpha + ps;
#pragma unroll
  for (int g = 0; g < 4; ++g) {
    int w = __builtin_amdgcn_cvt_pk_fp8_f32(p0[4 * g], p0[4 * g + 1], 0, false); p8[g] = __builtin_amdgcn_cvt_pk_fp8_f32(p0[4 * g + 2], p0[4 * g + 3], w, true);
    int u = __builtin_amdgcn_cvt_pk_fp8_f32(p1[4 * g], p1[4 * g + 1], 0, false); p8[4 + g] = __builtin_amdgcn_cvt_pk_fp8_f32(p1[4 * g + 2], p1[4 * g + 3], u, true); }
}
__device__ __forceinline__ void pv8(f32x16* o, const char* Vt, const v8i32 p8, int r32, int hi) {
  const int sw = (r32 >> 2) & 3, a0 = r32 * 64 + (((hi * 2) ^ sw) << 4), a1 = r32 * 64 + (((hi * 2 + 1) ^ sw) << 4);
#pragma unroll
  for (int d0 = 0; d0 < 4; ++d0) {
    const v8i32 vf = cat8(*reinterpret_cast<const v4i32*>(Vt + d0 * 2048 + a0), *reinterpret_cast<const v4i32*>(Vt + d0 * 2048 + a1));
    o[d0] = __builtin_amdgcn_mfma_scale_f32_32x32x64_f8f6f4(p8, vf, o[d0], 0, 0, 0, 127, 0, 127); }
}
__device__ __forceinline__ void qkt9(f32x16& p0, f32x16& p1, const char* Kn, const char* Kr, const v8i32* qf, const float init, int r32, int hi) {
#pragma unroll
  for (int r = 0; r < 16; ++r) { p0[r] = init; p1[r] = init; }
#pragma unroll
  for (int s = 0; s < 2; ++s) { const int c0 = s * 4 + hi * 2;
    const v8i32 a0 = cat8(*reinterpret_cast<const v4i32*>(Kn + KN8SW(r32, c0)), *reinterpret_cast<const v4i32*>(Kn + KN8SW(r32, c0 + 1)));
    const v8i32 a1 = cat8(*reinterpret_cast<const v4i32*>(Kn + 4096 + KN8SW(r32, c0)), *reinterpret_cast<const v4i32*>(Kn + 4096 + KN8SW(r32, c0 + 1)));
    p0 = __builtin_amdgcn_mfma_scale_f32_32x32x64_f8f6f4(a0, qf[s], p0, 0, 0, 0, 127, 0, 124);
    p1 = __builtin_amdgcn_mfma_scale_f32_32x32x64_f8f6f4(a1, qf[s], p1, 0, 0, 0, 127, 0, 124); }
  { const int c0 = hi * 2;
    const v8i32 a0 = cat8(*reinterpret_cast<const v4i32*>(Kr + KR8SW(r32, c0)), *reinterpret_cast<const v4i32*>(Kr + KR8SW(r32, c0 + 1)));
    const v8i32 a1 = cat8(*reinterpret_cast<const v4i32*>(Kr + 2048 + KR8SW(r32, c0)), *reinterpret_cast<const v4i32*>(Kr + 2048 + KR8SW(r32, c0 + 1)));
    p0 = __builtin_amdgcn_mfma_scale_f32_32x32x64_f8f6f4(a0, qf[2], p0, 0, 0, 0, 127, 0, 124);
    p1 = __builtin_amdgcn_mfma_scale_f32_32x32x64_f8f6f4(a1, qf[2], p1, 0, 0, 0, 127, 0, 124); }
}
__device__ __forceinline__ void partialSM9(f32x16& p0, f32x16& p1, float& m_run, float& alpha, const float thr2) {
  float pmax = p0[0];
#pragma unroll
  for (int r = 1; r < 16; ++r) pmax = fmaxf(pmax, p0[r]);
#pragma unroll
  for (int r = 0; r < 16; ++r) pmax = fmaxf(pmax, p1[r]);
  { auto rr = __builtin_amdgcn_permlane32_swap(__float_as_uint(pmax), __float_as_uint(pmax), false, false);
    pmax = fmaxf(__uint_as_float(rr[0]), __uint_as_float(rr[1])); }
  if (__builtin_expect(__all(pmax <= 7.0f + thr2), 1)) { alpha = 1.f; }
  else { const float delta = fmaxf(pmax - 7.0f, 0.f); alpha = __builtin_amdgcn_exp2f(-delta); m_run += delta;
#pragma unroll
    for (int r = 0; r < 16; ++r) { p0[r] -= delta; p1[r] -= delta; } }
}
__device__ __forceinline__ void attn_unit7(const unsigned char* __restrict__ Q8, int ldq, const unsigned char* __restrict__ Kn8, int ldk, const unsigned char* __restrict__ Kr8,
                                           const unsigned char* __restrict__ VT8, bf16_t* __restrict__ Ob, int ldo, const int NT, const float C, const float thr_raw, char* lds) {
  int tid_ = threadIdx.x; asm volatile("" : "+v"(tid_));
  const int tid = tid_, wid = tid >> 6, lane = tid & 63, r32 = lane & 31, hi = lane >> 5;
  char* Vt_lds = lds + G8_VT; char* Kn_lds = lds + G8_KN; char* Kr_lds = lds + G8_KR;
  float* ws = (float*)(lds + G8_WS) + wid * 64; float* li_l = ws; float* al_l = ws + 32;
  float m_reg = 0.f, l_reg = 0; f32x16 o[4] = {}; v8i32 qf[3];
  { const unsigned char* Qw = Q8 + (unsigned)((wid * 32 + r32) * ldq + hi * 32);
#pragma unroll
    for (int s = 0; s < 3; ++s) qf[s] = cat8(*reinterpret_cast<const v4i32*>(Qw + s * 64), *reinterpret_cast<const v4i32*>(Qw + s * 64 + 16)); }
  const int vtr = tid >> 2, vtc = tid & 3, vtst = vtr * 64 + ((vtc ^ ((vtr >> 2) & 3)) << 4);
  const int knr = tid >> 3, knc = tid & 7, knst = KN8SW(knr, knc);
  const int krr = (tid >> 2) & 63, krc = tid & 3, krst = KR8SW(krr, krc);
  const bool krw = tid < 256;
  unsigned vtoff = (unsigned)(tid * 16), knoff = (unsigned)(knr * ldk + knc * 16), kroff = (unsigned)(krr * 64 + krc * 16);
  v4i32 vt, kn, kr;
#define SLOAD() do { vt = *(const v4i32*)(VT8 + vtoff); kn = *(const v4i32*)(Kn8 + knoff); if (krw) kr = *(const v4i32*)(Kr8 + kroff); \
    vtoff += 8192u; knoff += 64u * (unsigned)ldk; kroff += 64u * 64u; } while (0)
#define SWRITE(b) do { *(v4i32*)(Vt_lds + (b) * 8192 + vtst) = vt; *(v4i32*)(Kn_lds + (b) * 8192 + knst) = kn; if (krw) *(v4i32*)(Kr_lds + (b) * 4096 + krst) = kr; } while (0)
#define RESC(a) do { if (__any((a) < 1.f)) { if (hi == 0) al_l[r32] = (a); asm volatile("s_waitcnt lgkmcnt(0)" ::: "memory"); \
    _Pragma("unroll") for (int d = 0; d < 4; ++d) _Pragma("unroll") for (int r = 0; r < 16; ++r) o[d][r] *= al_l[crow(r, hi)]; } } while (0)
  f32x16 pA0, pA1, pB0, pB1; float alA, alB; v8i32 p8;
  SLOAD(); SWRITE(0); __syncthreads();
  SLOAD();
  qkt9(pA0, pA1, Kn_lds, Kr_lds, qf, 7.0f - m_reg, r32, hi); partialSM9(pA0, pA1, m_reg, alA, thr_raw);
  SWRITE(1); __syncthreads();
  for (int j = 1; j + 1 < NT; j += 2) {
    SLOAD();
    qkt9(pB0, pB1, Kn_lds + 8192, Kr_lds + 4096, qf, 7.0f - m_reg, r32, hi);
    finishSM9(pA0, pA1, alA, l_reg, p8);
    pv8(o, Vt_lds, p8, r32, hi); partialSM9(pB0, pB1, m_reg, alB, thr_raw);
    __syncthreads(); SWRITE(0);
    RESC(alB); __syncthreads();
    if (j + 2 < NT) SLOAD();

    qkt9(pA0, pA1, Kn_lds, Kr_lds, qf, 7.0f - m_reg, r32, hi);
    finishSM9(pB0, pB1, alB, l_reg, p8);
    pv8(o, Vt_lds + 8192, p8, r32, hi); partialSM9(pA0, pA1, m_reg, alA, thr_raw);
    __syncthreads(); if (j + 2 < NT) SWRITE(1);
    RESC(alA); __syncthreads();
  }
  qkt9(pB0, pB1, Kn_lds + 8192, Kr_lds + 4096, qf, 7.0f - m_reg, r32, hi);
  finishSM9(pA0, pA1, alA, l_reg, p8);
  pv8(o, Vt_lds, p8, r32, hi); partialSM9(pB0, pB1, m_reg, alB, thr_raw);
  RESC(alB);
  finishSM9(pB0, pB1, alB, l_reg, p8);
  pv8(o, Vt_lds + 8192, p8, r32, hi);
  if (hi == 0) li_l[r32] = l_reg; asm volatile("s_waitcnt lgkmcnt(0)" ::: "memory");
  char* ost = lds + G8_LDS + wid * 8192;
#pragma unroll
  for (int r = 0; r < 16; ++r) { const int orow = crow(r, hi); const float rl = __builtin_amdgcn_rcpf(li_l[orow]);
#pragma unroll
    for (int d0 = 0; d0 < 4; ++d0) *(bf16_t*)(ost + orow * 256 + (d0 * 32 + r32) * 2) = (bf16_t)(cvtpk(o[d0][r] * rl, 0.f) & 0xffffu); }
  asm volatile("s_waitcnt lgkmcnt(0)" ::: "memory");
  { bf16_t* Og = Ob + (unsigned)(wid * 32 * ldo);
#pragma unroll
    for (int i = 0; i < 8; ++i) { const int q = i * 64 + lane, row = q >> 4, c16 = q & 15;
      *(u32x4*)(Og + (unsigned)(row * ldo + c16 * 8)) = *(const u32x4*)(ost + row * 256 + c16 * 16); } }
  __syncthreads();
#undef SLOAD
#undef SWRITE
#undef RESC
}
#define ALAS __attribute__((address_space(3)))
constexpr int R_K = 0, R_V = 3 * 16384, R_KR = 6 * 16384, R_WS = R_KR + 3 * 8192, ATT3_LDS = R_WS + 8 * 64 * 4;
__device__ __forceinline__ void attn_unit3(const bf16_t* __restrict__ Qb, int ldq, const bf16_t* __restrict__ Kh, const bf16_t* __restrict__ Krh, const bf16_t* __restrict__ Vh, int ldkv,
                                           bf16_t* __restrict__ Ob, int ldo, const int NT, const float C, const float thr_raw, ALAS char* lds) {
  int tid_ = threadIdx.x; asm volatile("" : "+v"(tid_));
  const int tid = tid_, wid = __builtin_amdgcn_readfirstlane(tid >> 6), lane = tid & 63, r32 = lane & 31, hi = lane >> 5;
  ALAS float* ws = (ALAS float*)(lds + R_WS) + wid * 64; ALAS float* li_l = ws; ALAS float* al_l = ws + 32;
  float m_reg = -1e30f, l_reg = 0; f32x16 o[4] = {}; bf16x8 qr[12];
  { const bf16_t* Qw = Qb + (unsigned)((wid * 32 + r32) * ldq + hi * 8);
#pragma unroll
    for (int d0 = 0; d0 < 12; ++d0) qr[d0] = *reinterpret_cast<const bf16x8*>(Qw + d0 * 16); }
  unsigned koA, koB, voA, voB, kro;
  { const int q0 = wid * 64 + lane, q1 = q0 + 512;
    koA = (unsigned)((q0 >> 4) * ldkv + (((q0 & 15) ^ ((q0 >> 4) & 15)) * 8)); koB = (unsigned)((q1 >> 4) * ldkv + (((q1 & 15) ^ ((q1 >> 4) & 15)) * 8));
    { const int st = q0 >> 5, kk = ((st >> 2) << 3) | ((q0 >> 2) & 7), k = (kk & ~0xC) | ((kk & 4) << 1) | ((kk & 8) >> 1), c = (st & 3) * 32 + (q0 & 3) * 8; voA = (unsigned)(k * ldkv + c); }
    { const int st = q1 >> 5, kk = ((st >> 2) << 3) | ((q1 >> 2) & 7), k = (kk & ~0xC) | ((kk & 4) << 1) | ((kk & 8) >> 1), c = (st & 3) * 32 + (q1 & 3) * 8; voB = (unsigned)(k * ldkv + c); }
    { const int r = q0 >> 3, cl = (q0 & 7) ^ ((r >> 1) & 7); kro = (unsigned)(r * 64 + cl * 8); } }
  const int vbl = (int)(unsigned)(__UINTPTR_TYPE__)lds + R_V + v_rd_base(lane);
  const int kl0 = r32 * 256, kx = ((r32 & 15) << 4), krl0 = r32 * 128, krx = (((r32 >> 1) & 7) << 4);
#define DMA(t, s) do { const bf16_t* kb_ = Kh + (size_t)(t) * 64 * ldkv; const bf16_t* vb_ = Vh + (size_t)(t) * 64 * ldkv; const bf16_t* rb_ = Krh + (size_t)(t) * 4096; \
    __builtin_amdgcn_global_load_lds((const unsigned*)(kb_ + koA), (ALAS unsigned*)(lds + R_K + (s) * 16384 + wid * 1024), 16, 0, 0); \
    __builtin_amdgcn_global_load_lds((const unsigned*)(kb_ + koB), (ALAS unsigned*)(lds + R_K + (s) * 16384 + 8192 + wid * 1024), 16, 0, 0); \
    __builtin_amdgcn_global_load_lds((const unsigned*)(vb_ + voA), (ALAS unsigned*)(lds + R_V + (s) * 16384 + wid * 1024), 16, 0, 0); \
    __builtin_amdgcn_global_load_lds((const unsigned*)(vb_ + voB), (ALAS unsigned*)(lds + R_V + (s) * 16384 + 8192 + wid * 1024), 16, 0, 0); \
    __builtin_amdgcn_global_load_lds((const unsigned*)(rb_ + kro), (ALAS unsigned*)(lds + R_KR + (s) * 8192 + wid * 1024), 16, 0, 0); } while (0)
#define KLD(d0, row32) (*(const ALAS bf16x8*)(Ks + kl0 + (row32) * 8192 + ((((d0) * 16 + hi * 8) * 2) ^ kx)))
#define KRLD(d0, row32) (*(const ALAS bf16x8*)(Krs + krl0 + (row32) * 4096 + ((((d0) * 16 + hi * 8) * 2) ^ krx)))
  f32x16 p0, p1; float mn, al; bf16x8 pa0, pa1, pa2, pa3;
  DMA(0, 0); DMA(1, 1);
  int s = 0;
  for (int j = 0; j < NT; ++j) {
    if (j + 1 < NT) asm volatile("s_waitcnt vmcnt(5)" ::: "memory"); else asm volatile("s_waitcnt vmcnt(0)" ::: "memory");
    __builtin_amdgcn_s_barrier(); asm volatile("" ::: "memory");
    if (j + 2 < NT) { const int s2 = s == 0 ? 2 : s - 1; DMA(j + 2, s2); }
    SBAR();
    { const ALAS char* Ks = lds + R_K + s * 16384; const ALAS char* Krs = lds + R_KR + s * 8192;
      p0 = f32x16{}; p1 = f32x16{};
      bf16x8 b0 = KLD(0, 0), b1 = KLD(0, 1);
#pragma unroll
      for (int d0 = 0; d0 < 12; ++d0) {
        bf16x8 n0, n1;
        if (d0 + 1 < 8) { n0 = KLD(d0 + 1, 0); n1 = KLD(d0 + 1, 1); } else if (d0 + 1 < 12) { n0 = KRLD(d0 + 1 - 8, 0); n1 = KRLD(d0 + 1 - 8, 1); }
        p0 = __builtin_amdgcn_mfma_f32_32x32x16_bf16(b0, qr[d0], p0, 0, 0, 0);
        p1 = __builtin_amdgcn_mfma_f32_32x32x16_bf16(b1, qr[d0], p1, 0, 0, 0);
        if (d0 + 1 < 12) { b0 = n0; b1 = n1; }
      } }
    partialSM(p0, p1, m_reg, mn, al, C, thr_raw);
    if (__any(al < 1.f)) { if (hi == 0) al_l[r32] = al; asm volatile("s_waitcnt lgkmcnt(0)" ::: "memory");
#pragma unroll
      for (int d = 0; d < 4; ++d)
#pragma unroll
        for (int r = 0; r < 16; ++r) o[d][r] *= al_l[crow(r, hi)]; }
    finishSM(p0, p1, al, l_reg, pa0, pa1, pa2, pa3); SBAR();
    pv_d0(o, vbl + s * 16384, pa0, pa1, pa2, pa3);
    SBAR();
    s = s == 2 ? 0 : s + 1;
  }
  if (hi == 0) li_l[r32] = l_reg; asm volatile("s_waitcnt lgkmcnt(0)" ::: "memory");
  bf16_t* Ow = Ob + (unsigned)(wid * 32 * ldo + r32);
#pragma unroll
  for (int r = 0; r < 16; ++r) { const int orow = crow(r, hi); const float rl = __builtin_amdgcn_rcpf(li_l[orow]);
#pragma unroll
    for (int d0 = 0; d0 < 4; ++d0) Ow[(unsigned)(orow * ldo + d0 * 32)] = (bf16_t)(cvtpk(o[d0][r] * rl, 0.f) & 0xffffu); }
  __syncthreads();
#undef DMA
#undef KLD
#undef KRLD
}
}
#define LAS __attribute__((address_space(3)))
typedef unsigned short bf16;
typedef unsigned v4u __attribute__((ext_vector_type(4)));
typedef float f32x4 __attribute__((ext_vector_type(4)));
constexpr int NWAVES = 8;
#ifndef PHMASK
#define PHMASK 0xFFFF
#endif
#define PHON(k) constexpr ((PHMASK >> (k)) & 1)
#ifndef REP_MASK
#define REP_MASK 0
#endif
#define REPS(k) for (int rep_ = 0; rep_ < (((REP_MASK >> (k)) & 1) ? 2 : 1); ++rep_)
constexpr int LDS_BYTES = 131072 + 1024;
__device__ __forceinline__ unsigned pk2(float lo, float hi) { unsigned r; asm volatile("v_cvt_pk_bf16_f32 %0, %1, %2" : "=v"(r) : "v"(lo), "v"(hi)); return r; }
__device__ __forceinline__ float bflo(unsigned w) { return __uint_as_float(w << 16); }
__device__ __forceinline__ float bfhi(unsigned w) { return __uint_as_float(w & 0xffff0000u); }
__device__ __forceinline__ float wave_sum(float v) {
#pragma unroll
    for (int o = 1; o < 64; o <<= 1) v += __shfl_xor(v, o);
    return v;
}
__device__ __forceinline__ int map_win(int n) {
    if (n < 3072) { const int base = n < 1536 ? 0 : 1536, r = n - base, head = r >> 7, pc = r & 127; return base + head * 128 + (pc >> 1) + (pc & 1) * 64; }
    if (n < 5632) return n;
    if (n < 9728) return n + 64;
    const int pc = n - 9728; if (pc < 64) return 5632 + (pc >> 1) + (pc & 1) * 32;
    return -1;
}
__device__ __forceinline__ int map_wuq(int n) {
    if (n < 2048) return (n >> 7) * 192 + (n & 127);
    const int r = n - 2048, head = r >> 6, pc = r & 63; return head * 192 + 128 + (pc >> 1) + (pc & 1) * 32;
}
typedef float f32x2_ __attribute__((ext_vector_type(2)));
template <int MAP>
__device__ __forceinline__ void transpose_item(const float* __restrict__ W, int K, int N, int Np, const float* __restrict__ gain, bf16* __restrict__ WT, LAS float* scr, int item, int lane) {
    const int nblk = Np / 32, kb = item / nblk, nb = item % nblk, k0 = 64 * kb, n0 = 32 * nb;
    f32x4 v[8];
#pragma unroll
    for (int i = 0; i < 8; ++i) {
        const int idx = i * 64 + lane, kk = idx >> 3, np = n0 + (idx & 7) * 4;
        const float* row = W + (size_t)(k0 + kk) * N;
        int col = np, ilv = -1;
        int half = 64;
        if (MAP == 1) {
            if (np < 3072) { const int base = np < 1536 ? 0 : 1536, r = np - base; ilv = base + (r >> 7) * 128 + ((r & 127) >> 1); }
            else if (np < 5632) col = np;
            else if (np < 9728) col = np + 64;
            else if (np < 9792) { ilv = 5632 + ((np - 9728) >> 1); half = 32; }
            else col = -1;
        } else if (MAP == 2) {
            if (np < 2048) col = (np >> 7) * 192 + (np & 127);
            else { const int r = np - 2048; ilv = (r >> 6) * 192 + 128 + ((r & 63) >> 1); half = 32; }
        }
        if (ilv >= 0) { const f32x2_ a = *(const f32x2_*)(row + ilv), b = *(const f32x2_*)(row + ilv + half); v[i] = (f32x4){a.x, b.x, a.y, b.y}; }
        else if (col >= 0) v[i] = *(const f32x4*)(row + col);
        else v[i] = (f32x4){0.f, 0.f, 0.f, 0.f};
    }
#pragma unroll
    for (int i = 0; i < 8; ++i) {
        const int idx = i * 64 + lane, kk = idx >> 3, c4 = (idx & 7) * 4;
        const float g = gain ? gain[k0 + kk] : 1.f;
        scr[kk * 33 + c4 + 0] = v[i].x * g; scr[kk * 33 + c4 + 1] = v[i].y * g; scr[kk * 33 + c4 + 2] = v[i].z * g; scr[kk * 33 + c4 + 3] = v[i].w * g;
    }
    asm volatile("s_waitcnt lgkmcnt(0)" ::: "memory");
    const int c = lane & 7;
#pragma unroll
    for (int j = 0; j < 4; ++j) { const int n = (lane >> 3) + 8 * j; const LAS float* s = scr + (8 * c) * 33 + n;
        v4u o; o.x = pk2(s[0 * 33], s[1 * 33]); o.y = pk2(s[2 * 33], s[3 * 33]); o.z = pk2(s[4 * 33], s[5 * 33]); o.w = pk2(s[6 * 33], s[7 * 33]);
        *(v4u*)(WT + (size_t)(n0 + n) * K + k0 + 8 * c) = o; }
    asm volatile("s_waitcnt lgkmcnt(0)" ::: "memory");
}
__device__ __forceinline__ void rms_rows(const float* __restrict__ x, bf16* __restrict__ H, int gw, int NGW, int lane) {
    for (int m = gw; m < S_; m += NGW) {
        const f32x4* xr = (const f32x4*)(x + (size_t)m * DM) + lane; f32x4 v[8]; float s = 0.f;
#pragma unroll
        for (int j = 0; j < 8; ++j) { v[j] = xr[64 * j]; s += (v[j].x * v[j].x + v[j].y * v[j].y) + (v[j].z * v[j].z + v[j].w * v[j].w); }
        const float rstd = 1.f / sqrtf(wave_sum(s) * (1.f / DM) + EPS_);
        unsigned long long* o8 = (unsigned long long*)(H + (size_t)m * DM) + lane;
#pragma unroll
        for (int j = 0; j < 8; ++j) o8[64 * j] = (unsigned long long)pk2(v[j].x * rstd, v[j].y * rstd) | ((unsigned long long)pk2(v[j].z * rstd, v[j].w * rstd) << 32);
    }
}
__device__ __forceinline__ void rstd_rows_b(const bf16* __restrict__ X, float* __restrict__ R, int gw, int NGW, int lane) {
    for (int m = gw; m < S_; m += NGW) {
        const v4u* xr = (const v4u*)(X + (size_t)m * DM) + lane; float s = 0.f;
#pragma unroll
        for (int j = 0; j < 4; ++j) { const v4u w = xr[64 * j];
            const float a0 = bflo(w.x), a1 = bfhi(w.x), a2 = bflo(w.y), a3 = bfhi(w.y), a4 = bflo(w.z), a5 = bfhi(w.z), a6 = bflo(w.w), a7 = bfhi(w.w);
            s += (a0 * a0 + a1 * a1) + (a2 * a2 + a3 * a3) + (a4 * a4 + a5 * a5) + (a6 * a6 + a7 * a7); }
        const float rstd = 1.f / sqrtf(wave_sum(s) * (1.f / DM) + EPS_);
        if (lane == 0) R[m] = rstd;
    }
}
__device__ __forceinline__ void rms_rows_b(const bf16* __restrict__ X, bf16* __restrict__ H, int gw, int NGW, int lane) {
    for (int m = gw; m < S_; m += NGW) {
        const v4u* xr = (const v4u*)(X + (size_t)m * DM) + lane; v4u w[4]; float s = 0.f;
#pragma unroll
        for (int j = 0; j < 4; ++j) { w[j] = xr[64 * j];
            const float a0 = bflo(w[j].x), a1 = bfhi(w[j].x), a2 = bflo(w[j].y), a3 = bfhi(w[j].y), a4 = bflo(w[j].z), a5 = bfhi(w[j].z), a6 = bflo(w[j].w), a7 = bfhi(w[j].w);
            s += (a0 * a0 + a1 * a1) + (a2 * a2 + a3 * a3) + (a4 * a4 + a5 * a5) + (a6 * a6 + a7 * a7); }
        const float rstd = 1.f / sqrtf(wave_sum(s) * (1.f / DM) + EPS_);
        v4u* hr = (v4u*)(H + (size_t)m * DM) + lane;
#pragma unroll
        for (int j = 0; j < 4; ++j) { v4u o; o.x = pk2(bflo(w[j].x) * rstd, bfhi(w[j].x) * rstd); o.y = pk2(bflo(w[j].y) * rstd, bfhi(w[j].y) * rstd);
            o.z = pk2(bflo(w[j].z) * rstd, bfhi(w[j].z) * rstd); o.w = pk2(bflo(w[j].w) * rstd, bfhi(w[j].w) * rstd); hr[64 * j] = o; }
    }
}
__device__ __forceinline__ void rms512_inplace(bf16* __restrict__ A, int gw, int NGW, int lane) {
    for (int m = gw; m < S_; m += NGW) {
        v4u* p = (v4u*)(A + (size_t)m * 512) + lane; const v4u w = *p;
        float f[8] = {bflo(w.x), bfhi(w.x), bflo(w.y), bfhi(w.y), bflo(w.z), bfhi(w.z), bflo(w.w), bfhi(w.w)}; float s = 0.f;
#pragma unroll
        for (int e = 0; e < 8; ++e) s += f[e] * f[e];
        const float rstd = 1.f / sqrtf(wave_sum(s) * (1.f / 512) + EPS_);
        v4u o; o.x = pk2(f[0] * rstd, f[1] * rstd); o.y = pk2(f[2] * rstd, f[3] * rstd); o.z = pk2(f[4] * rstd, f[5] * rstd); o.w = pk2(f[6] * rstd, f[7] * rstd); *p = o;
    }
}
#define XB_TMO      128
#define XB_XCNT(j)  (256  + 64 * (j))
#define XB_XSUB(j)  (1280 + 64 * (j))
#define XB_XGEN(j)  (2304 + 64 * (j))
#define XB_TOP      3328
#define XB_TOPGEN   3392
#define XCD_BAR_WORDS 3456
#define XB_SPIN_CAP (1u << 23)

__device__ __forceinline__ unsigned xb_ld(unsigned* p)              { return __hip_atomic_load(p, __ATOMIC_RELAXED, __HIP_MEMORY_SCOPE_AGENT); }
__device__ __forceinline__ unsigned xb_add(unsigned* p, unsigned v) { return __hip_atomic_fetch_add(p, v, __ATOMIC_RELAXED, __HIP_MEMORY_SCOPE_AGENT); }
__device__ __forceinline__ unsigned xb_xcc_id() { return (unsigned)__builtin_amdgcn_s_getreg((3 << 11) | 20) & 0xFu; }
#define XB_SPIN(cond, bar) do { unsigned _sp = 0; while (cond) { __builtin_amdgcn_s_sleep(1); \
    if ((++_sp & 255u) == 0u) { if (xb_ld(&(bar)[XB_TMO])) break; if (_sp > XB_SPIN_CAP) { atomicAdd(&(bar)[XB_TMO], 1u); break; } } } } while (0)

struct XcdBarrier {
    unsigned* bar; unsigned x;
    volatile LAS unsigned* st;
};

__device__ __forceinline__ XcdBarrier xcd_barrier_post(unsigned* bar, volatile LAS unsigned* st) {
    XcdBarrier b; b.bar = bar; b.x = xb_xcc_id(); b.st = st;
    if (threadIdx.x == 0) (void)xb_add(&bar[XB_XCNT(b.x)], 1u);
    return b;
}
__device__ __forceinline__ void xcd_barrier_complete(unsigned* bar, unsigned x, unsigned& nloc, unsigned& nx) {
    const unsigned G = gridDim.x * gridDim.y * gridDim.z;
    unsigned sum, cnt, mine, sp = 0u;
    for (;;) {
        sum = 0u; cnt = 0u; mine = 0u;
#pragma unroll
        for (unsigned j = 0; j < 16; ++j) { const unsigned c = xb_ld(&bar[XB_XCNT(j)]); sum += c; cnt += (c > 0u) ? 1u : 0u; mine = (j == x) ? c : mine; }
        if (sum == G) break;
        __builtin_amdgcn_s_sleep(1);
        if ((++sp & 255u) == 0u) { if (xb_ld(&bar[XB_TMO])) break; if (sp > XB_SPIN_CAP) { atomicAdd(&bar[XB_TMO], 1u); break; } }
    }
    nloc = mine > 0u ? mine : 1u; nx = cnt > 0u ? cnt : 1u;
}

__device__ __forceinline__ void xcd_barrier(const XcdBarrier& b) {
    asm volatile("s_waitcnt vmcnt(0)" ::: "memory");
    __syncthreads();
    if (threadIdx.x == 0) {
        unsigned* bar = b.bar;
        __builtin_amdgcn_s_waitcnt(0);
        unsigned nloc = b.st[0], nx = b.st[1];
        if (nloc == 0u) { xcd_barrier_complete(bar, b.x, nloc, nx); b.st[0] = nloc; b.st[1] = nx; }
        const unsigned old = xb_add(&bar[XB_XSUB(b.x)], 1u);
        const unsigned gen = old / nloc;
        if (old + 1u == (gen + 1u) * nloc) {
            __builtin_amdgcn_fence(__ATOMIC_RELEASE, "agent");
            asm volatile("s_waitcnt vmcnt(0)" ::: "memory");
            const unsigned og = xb_add(&bar[XB_TOP], 1u);
            const unsigned tg = og / nx;
            if (og + 1u == (tg + 1u) * nx) xb_add(&bar[XB_TOPGEN], 1u);
            else XB_SPIN(xb_ld(&bar[XB_TOPGEN]) == tg, bar);
            __builtin_amdgcn_fence(__ATOMIC_ACQUIRE, "agent");
            xb_add(&bar[XB_XGEN(b.x)], 1u);
            asm volatile("s_waitcnt vmcnt(0)" ::: "memory");
        } else {
            XB_SPIN(xb_ld(&bar[XB_XGEN(b.x)]) == gen, bar);
            __builtin_amdgcn_fence(__ATOMIC_ACQUIRE, "agent");
            asm volatile("s_waitcnt vmcnt(0)" ::: "memory");
        }
    }
    __syncthreads();
}

struct Args { const float* in[18]; float* out; unsigned char* ws; int ph_lo, ph_hi; };
constexpr int PH_PER_LAYER = 11, PH_TOTAL = DEPTH_ * PH_PER_LAYER + 1;

#define GAS __attribute__((address_space(1)))
#define WB(off) ((bf16*)(GAS bf16*)(ws + (off)))
#define WF(off) ((float*)(GAS float*)(ws + (off)))
#define GIN(k) ((const float*)(const GAS float*)ap->in[k])
#define GOUT ((float*)(GAS float*)ap->out)
#define SEAM(k) do { RELOAD(); if ((k) + 1 < ap->ph_hi) { if ((k) == 0) { __syncthreads(); grid.sync(); } else xcd_barrier(xbar); } RELOAD(); } while (0)
#define GEMM_PHASE(MODE, Aoff, Boff, N_, K_, F0, FO) do { pg8::Gemm g{WB(Aoff), WB(Boff), S_, (N_), (K_)}; int G_ = gridDim.x, bx_ = blockIdx.x; asm volatile("" : "+s"(G_), "+s"(bx_)); pg8::StaticOrder SO; SO.init(S_, (N_), G_, bx_); \
    pg8::Epi<pg8::MODE> E{{ws, (F0), (FO)}}; pg8::gemm_phase<pg8::Epi<pg8::MODE>, pg8::StaticOrder, true, true>((LAS unsigned char*)lds, g, SO, E); } while (0)
#define GEMM_PHASE_A(MODE, Aptr, Boff, N_, K_, F0, FO) do { pg8::Gemm g{(Aptr), WB(Boff), S_, (N_), (K_)}; int G_ = gridDim.x, bx_ = blockIdx.x; asm volatile("" : "+s"(G_), "+s"(bx_)); pg8::StaticOrder SO; SO.init(S_, (N_), G_, bx_); \
    pg8::Epi<pg8::MODE> E{{ws, (F0), (FO)}}; pg8::gemm_phase<pg8::Epi<pg8::MODE>, pg8::StaticOrder, true, true>((LAS unsigned char*)lds, g, SO, E); } while (0)

__global__ void __launch_bounds__(NWAVES * 64, 2) mega_fwd(Args args) {
    extern __shared__ __attribute__((aligned(16))) unsigned char lds[];
    cg::grid_group grid = cg::this_grid();
    { volatile LAS unsigned* st0 = (volatile LAS unsigned*)((LAS unsigned char*)lds + 131072); if (threadIdx.x < 64) st0[threadIdx.x] = 0u; }
    __syncthreads();
    XcdBarrier xbar = xcd_barrier_post((unsigned*)args.ws, (volatile LAS unsigned*)((LAS unsigned char*)lds + 131072));
    typedef const __attribute__((address_space(4))) Args* ArgsP; ArgsP ap = (ArgsP)__builtin_amdgcn_kernarg_segment_ptr();
    unsigned char* ws;
#define RELOAD() do { asm volatile("" : "+s"(ap)); ws = ap->ws; asm volatile("" : "+s"(ws)); } while (0)
#define TIDS int tid_ = threadIdx.x, G_ = gridDim.x, bx_ = blockIdx.x; asm volatile("" : "+v"(tid_), "+s"(G_), "+s"(bx_)); const int tid = tid_, lane = tid & 63, wave = __builtin_amdgcn_readfirstlane(tid >> 6); const int G = G_, bx = bx_; \
    const int gw = bx * NWAVES + wave, NGW = G * NWAVES; const long gt = (long)bx * 512 + tid, NGT = (long)G * 512; (void)lane; (void)gw; (void)NGW; (void)gt; (void)NGT;
#pragma nounroll
    for (int l = 0; l < DEPTH_; ++l) {
#define pb (l * PH_PER_LAYER)
#define IN(k) (ap->ph_lo <= pb + (k) && pb + (k) < ap->ph_hi)
        RELOAD();
        if (IN(0)) { if PHON(0) REPS(0) {
            TIDS
            const float *norm_mix = GIN(2) + (size_t)l * DM, *w_in = GIN(3) + (size_t)l * DM * NIN, *norm_q = GIN(5) + (size_t)l * QLORA, *w_uq = GIN(6) + (size_t)l * QLORA * 3072,
                        *norm_kv = GIN(7) + (size_t)l * KVLORA, *w_ukv = GIN(8) + (size_t)l * KVLORA * 4096, *w_oa = GIN(9) + (size_t)l * 512 * DM, *w_ob = GIN(10) + (size_t)l * DM * DM,
                        *w_out = GIN(11) + (size_t)l * DM * DM, *norm_ffn = GIN(12) + (size_t)l * DM, *w_up = GIN(13) + (size_t)l * DM * 2 * DFF, *w_down = GIN(16) + (size_t)l * DFF * DM;
            LAS float* scr = (LAS float*)((LAS unsigned char*)lds + wave * 16384);
            constexpr int I_IN = (DM / 64) * (NINP / 32), I_UQ = (512 / 64) * (3072 / 32), I_UKV = (512 / 64) * (4096 / 32), I_OA = (512 / 64) * (DM / 32), I_OB = (DM / 64) * (DM / 32), I_OUT = I_OB,
                          I_UP = (DM / 64) * (2 * DFF / 32), I_DN = (DFF / 64) * (DM / 32);
            constexpr int NITEMS = I_IN + I_UQ + I_UKV + I_OA + I_OB + I_OUT + I_UP + I_DN;
            for (int it = gw; it < NITEMS; it += NGW) {
                int r = it;
                if (r < I_IN) { transpose_item<1>(w_in, DM, NIN, NINP, norm_mix, WB(WS_WIN), scr, r, lane); continue; } r -= I_IN;
                if (r < I_UQ) { transpose_item<2>(w_uq, 512, 3072, 3072, norm_q, WB(WS_WUQ), scr, r, lane); continue; } r -= I_UQ;
                if (r < I_UKV) { transpose_item<0>(w_ukv, 512, 4096, 4096, norm_kv, WB(WS_WUKV), scr, r, lane); continue; } r -= I_UKV;
                if (r < I_OA) { transpose_item<0>(w_oa, 512, DM, DM, nullptr, WB(WS_WOA), scr, r, lane); continue; } r -= I_OA;
                if (r < I_OB) { transpose_item<0>(w_ob, DM, DM, DM, nullptr, WB(WS_WOB), scr, r, lane); continue; } r -= I_OB;
                if (r < I_OUT) { transpose_item<0>(w_out, DM, DM, DM, nullptr, WB(WS_WOUT), scr, r, lane); continue; } r -= I_OUT;
                if (r < I_UP) { transpose_item<0>(w_up, DM, 2 * DFF, 2 * DFF, norm_ffn, WB(WS_WUP), scr, r, lane); continue; } r -= I_UP;
                transpose_item<0>(w_down, DFF, DM, DM, nullptr, WB(WS_WDN), scr, r, lane);
            }
            if (l == 0) {
                const int* positions = (const int*)GIN(1);
                for (long i = gt; i < (long)S_ * 96; i += NGT) {
                    const int s = (int)(i / 96), j = (int)(i % 96); const double pos = (double)positions[s];
                    const bool isA = j < 64; const int e = isA ? j : j - 64;
                    double base = isA ? 0.8659643233600653 : 0.7498942093324559, inv = 1.0;
#pragma unroll
                    for (int bit = 0; bit < 6; ++bit) { if ((e >> bit) & 1) inv *= base; base *= base; }
                    double t = pos * inv * 0.15915494309189535; t -= rint(t);
                    const float tf = (float)t;
                    float* dst = isA ? WF(WS_ROPEA) + ((size_t)s * 64 + e) * 2 : WF(WS_ROPEB) + ((size_t)s * 32 + e) * 2;
                    dst[0] = __builtin_amdgcn_cosf(tf); dst[1] = __builtin_amdgcn_sinf(tf);
                }
            }
            if (l == 0) { rms_rows(GIN(0), WB(WS_H), gw, NGW, lane); for (long i = gt; i < S_; i += NGT) WF(WS_RSTD)[i] = 1.f; } else rstd_rows_b((const bf16*)(GAS bf16*)((GAS unsigned char*)ap->out + 67108864), WF(WS_RSTD), gw, NGW, lane);
        } SEAM(pb + 0); }
        if (IN(1)) { if PHON(1) REPS(1) {
            if (l == 0) GEMM_PHASE(EP_IN, WS_H, WS_WIN, NINP, DM, GIN(4) + (size_t)l * 4096, nullptr); else GEMM_PHASE_A(EP_IN, (const bf16*)(GAS bf16*)((GAS unsigned char*)ap->out + 67108864), WS_WIN, NINP, DM, GIN(4) + (size_t)l * 4096, nullptr);
        } SEAM(pb + 1); }
        if (IN(2)) { if PHON(2) {
            TIDS
            rms512_inplace(WB(WS_QL), gw, NGW, lane); rms512_inplace(WB(WS_KVL), gw, NGW, lane);
            const float scale = 0.08838834764831845f, C = scale * 1.4426950408889634f;
            REPS(2) for (int u = bx; u < 768; u += G) {
                const int g = u >> 8, rem = u & 255, head = rem >> 6, idx = rem & 63;
                const int dsh = 2 * g, d = 1 << dsh, L = S_ >> dsh, nqb = L >> 8, r = idx / nqb, qb = idx % nqb, t0 = qb * 256;
                int ks = t0 - 64; if (ks < 0) ks = 0; if (ks > L - 384) ks = L - 384;
                const int pitch = d * WA; const int hc = (g * 4 + head) * 128;
                const bf16* Qp = WB(WS_QA) + (size_t)(r + d * t0) * WA + hc; const bf16* Kp = WB(WS_KA) + (size_t)(r + d * ks) * WA + hc; const bf16* Vp = WB(WS_VA) + (size_t)(r + d * ks) * WA + hc;
                bf16* Op = WB(WS_OG) + (size_t)(r + d * t0) * WA + hc; float* Lp = WF(WS_LSE) + (size_t)(r + d * t0) * 12 + g * 4 + head;
                att::attn_unit<0, true>(Qp, pitch, Kp, pitch, Kp, Vp, pitch, Op, pitch, Lp, d * 12, 6, t0 - ks, C, 8.f / scale, scale, (char*)lds);
            }
        } SEAM(pb + 2); }
        if (IN(3)) { if PHON(3) REPS(3) {
            GEMM_PHASE(EP_CQ, WS_QL, WS_WUQ, 3072, 512, nullptr, nullptr);
            GEMM_PHASE(EP_CKV, WS_KVL, WS_WUKV, 4096, 512, nullptr, nullptr);
            TIDS
            const float* LSE = WF(WS_LSE); const bf16* OG = WB(WS_OG); bf16* OA = WB(WS_OA);
            for (long i = gt; i < (long)S_ * 64; i += NGT) {
                const int s = (int)(i >> 6), hh = (int)(i >> 4) & 3, ch = (int)i & 15;
                const float l0 = LSE[(size_t)s * 12 + hh], l1 = LSE[(size_t)s * 12 + 4 + hh], l2 = LSE[(size_t)s * 12 + 8 + hh];
                const float mx = fmaxf(l0, fmaxf(l1, l2)); float w0 = __expf(l0 - mx), w1 = __expf(l1 - mx), w2 = __expf(l2 - mx); const float inv = 1.f / (w0 + w1 + w2); w0 *= inv; w1 *= inv; w2 *= inv;
                const v4u a = *(const v4u*)(OG + (size_t)s * WA + hh * 128 + ch * 8), b = *(const v4u*)(OG + (size_t)s * WA + (4 + hh) * 128 + ch * 8), c = *(const v4u*)(OG + (size_t)s * WA + (8 + hh) * 128 + ch * 8);
                v4u o;
                o.x = pk2(w0 * bflo(a.x) + w1 * bflo(b.x) + w2 * bflo(c.x), w0 * bfhi(a.x) + w1 * bfhi(b.x) + w2 * bfhi(c.x));
                o.y = pk2(w0 * bflo(a.y) + w1 * bflo(b.y) + w2 * bflo(c.y), w0 * bfhi(a.y) + w1 * bfhi(b.y) + w2 * bfhi(c.y));
                o.z = pk2(w0 * bflo(a.z) + w1 * bflo(b.z) + w2 * bflo(c.z), w0 * bfhi(a.z) + w1 * bfhi(b.z) + w2 * bfhi(c.z));
                o.w = pk2(w0 * bflo(a.w) + w1 * bflo(b.w) + w2 * bflo(c.w), w0 * bfhi(a.w) + w1 * bfhi(b.w) + w2 * bfhi(c.w));
                *(v4u*)(OA + (size_t)s * 512 + hh * 128 + ch * 8) = o;
            }
        } SEAM(pb + 3); }
        if (IN(4)) { if PHON(4) REPS(4) {
            int G = gridDim.x, bx = blockIdx.x; asm volatile("" : "+s"(G), "+s"(bx));
            const float scale = 0.07216878364870323f, C = scale * 1.4426950408889634f;
#if defined(ATT_PROBE)
            for (int u = bx; u < 1024; u += G) {
                const int xc = u & 7, rest = u >> 3, pair = (rest >> 5) * 8 + xc, head = pair >> 1, qb = (pair & 1) * 32 + (rest & 31);
                att::attn_unit2<4, ATT_PROBE>(WB(WS_QB) + (size_t)qb * 256 * 3072 + head * 192, 3072, WB(WS_KN) + head * 128, 2048, WB(WS_KPE), WB(WS_VB) + head * 128, 2048,
                                   WB(WS_T) + (size_t)qb * 256 * 2048 + head * 128, 2048, S_ / 64, C, 8.f / scale, (char*)lds);
            }
            __syncthreads(); grid.sync();
#endif
            for (int u = bx; u < 1024; u += G) {
                const int xc = u & 7, rest = u >> 3, pair = (rest >> 5) * 8 + xc, head = pair >> 1, qb = (pair & 1) * 32 + (rest & 31);
                att::attn_unit7((const unsigned char*)(GAS unsigned char*)(ws + WS_QB) + (size_t)qb * 256 * 3072 + head * 192, 3072, (const unsigned char*)(GAS unsigned char*)(ws + WS_KN) + head * 128, 2048,
                                (const unsigned char*)(GAS unsigned char*)(ws + WS_KPE), (const unsigned char*)(GAS unsigned char*)(ws + WS_VB) + (size_t)head * (S_ / 64) * 8192,
                                WB(WS_H) + (size_t)qb * 256 * 2048 + head * 128, 2048, S_ / 64, C, 1.4426950408889634f, (char*)lds);
            }
#ifndef NO_YA
            GEMM_PHASE(EP_YA, WS_OA, WS_WOA, DM, 512, nullptr, nullptr);
#endif
        } SEAM(pb + 4); }
        if (IN(5)) { if PHON(5) REPS(5) {
            GEMM_PHASE(EP_YB, WS_H, WS_WOB, DM, DM, nullptr, nullptr);
        } SEAM(pb + 5); }
        if (IN(6)) { if PHON(6) {
            GEMM_PHASE(EP_RES, WS_MERGED, WS_WOUT, DM, DM, (l == 0 ? GIN(0) : (const float*)nullptr), GOUT);
        } SEAM(pb + 6); }
        if (IN(7)) { if PHON(7) { TIDS rstd_rows_b((const bf16*)(GAS bf16*)((GAS unsigned char*)ap->out + 67108864), WF(WS_RSTD), gw, NGW, lane); } SEAM(pb + 7); }
        if (IN(8)) { if PHON(8) REPS(8) {
            GEMM_PHASE_A(EP_U, (const bf16*)(GAS bf16*)((GAS unsigned char*)ap->out + 67108864), WS_WUP, 2 * DFF, DM, nullptr, nullptr);
        } SEAM(pb + 8); }
        if (IN(9)) { if PHON(9) REPS(9) {
            TIDS
            const float *cw = GIN(14) + (size_t)l * 3 * 2 * DFF, *cb = GIN(15) + (size_t)l * 2 * DFF; const bf16* U = WB(WS_U); bf16* GG = WB(WS_G);
            constexpr int NCG = DFF / 8;
            const int nsl = (int)(NGT / NCG), rps = (S_ + nsl - 1) / nsl, cgp = (int)(gt % NCG), sl = (int)(gt / NCG);
            if (sl < nsl && sl * rps < S_) {
                const int c = cgp * 8, sb = sl * rps, se = (sb + rps < S_) ? sb + rps : S_;
                float wa[3][8], wb[3][8], ba[8], bb[8];
#pragma unroll
                for (int t = 0; t < 3; ++t)
#pragma unroll
                    for (int e = 0; e < 8; ++e) { wa[t][e] = cw[(size_t)t * 2 * DFF + c + e]; wb[t][e] = cw[(size_t)t * 2 * DFF + DFF + c + e]; }
#pragma unroll
                for (int e = 0; e < 8; ++e) { ba[e] = cb[c + e]; bb[e] = cb[DFF + c + e]; }
                const v4u z = {0u, 0u, 0u, 0u};
#define LDU(s, off) (((s) >= 0 && (s) < S_) ? *(const v4u*)(U + (size_t)(s) * 2 * DFF + (off) + c) : z)
                v4u ra[6], rb[6], na[4], nb[4];
#pragma unroll
                for (int k = 0; k < 6; ++k) { ra[k] = LDU(sb - 1 + k, 0); rb[k] = LDU(sb - 1 + k, DFF); }
                for (int s = sb; s < se; s += 4) {
#pragma unroll
                    for (int k = 0; k < 4; ++k) { na[k] = LDU(s + 5 + k, 0); nb[k] = LDU(s + 5 + k, DFF); }
#define CV(e, P, Cc, Nn, W, Bv) (Bv[e] + W[0][e] * ((e & 1) ? bfhi(P[e >> 1]) : bflo(P[e >> 1])) + W[1][e] * ((e & 1) ? bfhi(Cc[e >> 1]) : bflo(Cc[e >> 1])) + W[2][e] * ((e & 1) ? bfhi(Nn[e >> 1]) : bflo(Nn[e >> 1])))
#pragma unroll
                    for (int k = 0; k < 4; ++k) {
                        if (s + k < se) {
                            float ga[8];
#pragma unroll
                            for (int e = 0; e < 8; ++e) { const float ua = CV(e, ra[k], ra[k + 1], ra[k + 2], wa, ba), ub = CV(e, rb[k], rb[k + 1], rb[k + 2], wb, bb); ga[e] = ua * __builtin_amdgcn_rcpf(1.f + __expf(-ua)) * ub; }
                            v4u o; o.x = pk2(ga[0], ga[1]); o.y = pk2(ga[2], ga[3]); o.z = pk2(ga[4], ga[5]); o.w = pk2(ga[6], ga[7]);
                            *(v4u*)(GG + (size_t)(s + k) * DFF + c) = o;
                        }
                    }
#undef CV
                    ra[0] = ra[4]; ra[1] = ra[5]; rb[0] = rb[4]; rb[1] = rb[5];
#pragma unroll
                    for (int k = 0; k < 4; ++k) { ra[2 + k] = na[k]; rb[2 + k] = nb[k]; }
                }
#undef LDU
            }
        } SEAM(pb + 9); }
        if (IN(10)) { if PHON(10) {
            GEMM_PHASE(EP_RES, WS_G, WS_WDN, DM, DFF, (const float*)nullptr, GOUT);
        } SEAM(pb + 10); }
#undef IN
#undef pb
    }
    RELOAD();
    if (ap->ph_lo <= PH_TOTAL - 1 && PH_TOTAL - 1 < ap->ph_hi) {
        TIDS
        const bf16* XBp = (const bf16*)(GAS bf16*)((GAS unsigned char*)ap->out + 67108864); float* outp = GOUT; const float* gfin = GIN(17);
        v4u rw[8][4];
#pragma unroll
        for (int i = 0; i < 8; ++i) { const int row = gw + i * NGW;
#pragma unroll
            for (int j = 0; j < 4; ++j) rw[i][j] = row < S_ ? ((const v4u*)(XBp + (size_t)row * DM))[64 * j + lane] : (v4u){0u, 0u, 0u, 0u}; }
        asm volatile("s_waitcnt vmcnt(0)" ::: "memory");
        { XcdBarrier xb_; xb_.bar = (unsigned*)ws; xb_.x = xb_xcc_id(); xb_.st = (volatile LAS unsigned*)((LAS unsigned char*)lds + 131072); xcd_barrier(xb_); }
#pragma unroll
        for (int i = 0; i < 8; ++i) { const int row = gw + i * NGW; float s = 0.f;
#pragma unroll
            for (int j = 0; j < 4; ++j) { const v4u w = rw[i][j];
                const float a0 = bflo(w.x), a1 = bfhi(w.x), a2 = bflo(w.y), a3 = bfhi(w.y), a4 = bflo(w.z), a5 = bfhi(w.z), a6 = bflo(w.w), a7 = bfhi(w.w);
                s += (a0 * a0 + a1 * a1) + (a2 * a2 + a3 * a3) + (a4 * a4 + a5 * a5) + (a6 * a6 + a7 * a7); }
            const float rstd = 1.f / sqrtf(wave_sum(s) * (1.f / DM) + EPS_);
            if (row < S_) {
#pragma unroll
                for (int j = 0; j < 4; ++j) { const v4u w = rw[i][j]; const int c = (64 * j + lane) * 8; const f32x4 g0 = *(const f32x4*)(gfin + c), g1 = *(const f32x4*)(gfin + c + 4);
                    f32x4 o0 = {bflo(w.x), bfhi(w.x), bflo(w.y), bfhi(w.y)}, o1 = {bflo(w.z), bfhi(w.z), bflo(w.w), bfhi(w.w)};
                    *(f32x4*)(outp + (size_t)row * DM + c) = o0 * rstd * g0; *(f32x4*)(outp + (size_t)row * DM + c + 4) = o1 * rstd * g1; } }
        }
    }
}

extern "C" void kernel_launch(void* const* d_in, const int* in_sizes, int n_in, void* d_out, int out_size, void* d_ws, size_t ws_size, hipStream_t stream) {
    static int grid = 0;
    if (grid == 0) {
        if (n_in != 18 || out_size != S_ * DM || ws_size < WS_END) { fprintf(stderr, "kernel_launch: unexpected shapes (n_in %d out %d ws %zu)\n", n_in, out_size, ws_size); grid = -1; return; }
        int dev = 0, cus = 0, per_cu = 0;
        hipGetDevice(&dev); hipDeviceGetAttribute(&cus, hipDeviceAttributeMultiprocessorCount, dev);
        if (hipFuncSetAttribute((const void*)mega_fwd, hipFuncAttributeMaxDynamicSharedMemorySize, LDS_BYTES) != hipSuccess) { fprintf(stderr, "kernel_launch: hipFuncSetAttribute failed\n"); grid = -1; return; }
        if (hipOccupancyMaxActiveBlocksPerMultiprocessor(&per_cu, (const void*)mega_fwd, NWAVES * 64, LDS_BYTES) != hipSuccess || per_cu < 1) { fprintf(stderr, "kernel_launch: occupancy query gave %d\n", per_cu); per_cu = 1; }
        (void)hipGetLastError();
        grid = cus * 1;
    }
    if (grid < 0) return;
    if (hipMemsetAsync(d_ws, 0, 16384, stream) != hipSuccess) { fprintf(stderr, "kernel_launch: hipMemsetAsync failed\n"); return; }
    Args a{};
    for (int i = 0; i < 18; ++i) a.in[i] = (const float*)d_in[i];
    a.out = (float*)d_out; a.ws = (unsigned char*)d_ws;
#ifndef MK_SPLIT
    a.ph_lo = 0; a.ph_hi = PH_TOTAL;
    void* kargs[] = {&a};
    hipError_t e = hipLaunchCooperativeKernel((const void*)mega_fwd, dim3(grid), dim3(NWAVES * 64), kargs, LDS_BYTES, stream);
    if (e != hipSuccess) fprintf(stderr, "cooperative launch failed: %s (grid %d)\n", hipGetErrorString(e), grid);
#else
    for (int ph = 0; ph < PH_TOTAL; ++ph) { a.ph_lo = ph; a.ph_hi = ph + 1; hipLaunchKernelGGL(mega_fwd, dim3(grid), dim3(NWAVES * 64), LDS_BYTES, stream, a); }
#endif
}
```

```cpp
#include <hip/hip_runtime.h>
#include <hip/hip_cooperative_groups.h>
#include <cstdio>
#include <cstdint>
#include <cmath>
namespace cg = cooperative_groups;

constexpr int S_ = 16384, DM = 2048, DEPTH_ = 2;
constexpr int WA = 1536, QLORA = 512, KVLORA = 512, QKROPE = 64, NIN = 9792, NINP = 9984;
constexpr int DFF = 5632;
constexpr float EPS_ = 1e-6f;
constexpr size_t MiB = 1u << 20;
constexpr size_t WS_ROPEA = 1 * MiB, WS_ROPEB = 9 * MiB, WS_RSTD = 13 * MiB;
constexpr size_t WS_WUP = 16 * MiB, WS_WDN = 60 * MiB, WS_WIN = 82 * MiB, WS_WUQ = 121 * MiB, WS_WUKV = 124 * MiB, WS_WOA = 128 * MiB, WS_WOB = 130 * MiB, WS_WOUT = 138 * MiB;
constexpr size_t WS_H = 146 * MiB;
constexpr size_t WS_QA = 210 * MiB, WS_KA = 258 * MiB, WS_VA = 306 * MiB;
constexpr size_t WS_KN = 210 * MiB, WS_VB = 274 * MiB, WS_OA = 338 * MiB;
constexpr size_t WS_OG = 354 * MiB, WS_QL = 402 * MiB;
constexpr size_t WS_T = 354 * MiB;
constexpr size_t WS_KVL = 418 * MiB, WS_KPE = 434 * MiB, WS_LSE = 436 * MiB, WS_GATES = 437 * MiB, WS_QB = 565 * MiB;
constexpr size_t WS_MERGED = 565 * MiB;
constexpr size_t WS_G = 82 * MiB, WS_U = 258 * MiB;
constexpr size_t WS_END = 661 * MiB;
namespace pg8 {
#define PG8_LAS __attribute__((address_space(3)))
typedef unsigned short bf16_t;
typedef short bf16x8 __attribute__((ext_vector_type(8)));
typedef float f32x4 __attribute__((ext_vector_type(4)));
typedef unsigned u32x4 __attribute__((ext_vector_type(4)));
constexpr int BM = 256, BK = 64, HALF = 128, HTB = HALF * BK * 2  , STAGE_BYTES = 8 * HTB, NXCD = 8, WGM = 4;

__host__ __device__ __forceinline__ int lds_byte(int r, int c) { const int st = (r >> 4) * 2 + (c >> 5), rr = r & 15, cc = c & 31, ob = rr * 64 + cc * 2; return st * 1024 + (ob ^ (((ob >> 9) & 1) << 5)); }
__host__ __device__ __forceinline__ void stage_rc(int b, int& R, int& C) { const int st = b / 1024, sb = b % 1024, swz = sb ^ (((sb >> 9) & 1) << 5); R = (st >> 1) * 16 + swz / 64; C = (st & 1) * 32 + (swz % 64) / 2; }
__host__ __device__ __forceinline__ int perm32(int rho) { const int n = rho >> 4, i = rho & 15; return 8 * (i >> 2) + 4 * n + (i & 3); }

struct Unit { int pm, pn; };
struct Gemm { const bf16_t* A; const bf16_t* Bt; int M, N, K; };

struct StaticOrder {
    int nM, nN, nwg, G, c;
    __host__ __device__ void init(int M, int N, int G_, int c_) { nM = M / BM; nN = N / BM; nwg = nM * nN; G = G_; c = c_; }
    __host__ __device__ bool next(int i, Unit& u) const {
        const long L = (long)i * G + c; if (L >= nwg) return false;
        int wgid = (int)L; { const int q = nwg / NXCD, r = nwg % NXCD, xcd = wgid % NXCD, off = wgid / NXCD; wgid = (xcd < r ? xcd * (q + 1) : r * (q + 1) + (xcd - r) * q) + off; }
        const int nig = WGM * nN, gid = wgid / nig, fm = gid * WGM, gsz = (nM - fm) < WGM ? (nM - fm) : WGM;
        u.pm = fm + ((wgid % nig) % gsz); u.pn = (wgid % nig) / gsz; return true;
    }
    __device__ __forceinline__ void a_ready(const Unit&) const {}
    __device__ __forceinline__ void done(const Unit&) const {}
};
__device__ __forceinline__ unsigned cvt_pk_bf16(float lo, float hi) { unsigned r; asm volatile("v_cvt_pk_bf16_f32 %0, %1, %2" : "=v"(r) : "v"(lo), "v"(hi)); return r; }
typedef float f32x2 __attribute__((ext_vector_type(2)));
typedef float f32x2 __attribute__((ext_vector_type(2)));
enum { EP_IN = 0, EP_CQ, EP_CKV, EP_YA, EP_YB, EP_RES, EP_U };
struct EpiP { unsigned char* ws; const float* f0; float* fo; };
#define EGAS __attribute__((address_space(1)))
#define WSB(off) ((EGAS bf16_t*)(p.ws + (off)))
#define WSF(off) ((const EGAS float*)(p.ws + (off)))
__device__ __forceinline__ void st8(EGAS bf16_t* dst, f32x4 v0, f32x4 v1) {
    u32x4 w; w.x = cvt_pk_bf16(v0[0], v0[1]); w.y = cvt_pk_bf16(v0[2], v0[3]); w.z = cvt_pk_bf16(v1[0], v1[1]); w.w = cvt_pk_bf16(v1[2], v1[3]); *(EGAS u32x4*)dst = w; }
__device__ __forceinline__ void st8nt(EGAS bf16_t* dst, f32x4 v0, f32x4 v1) {
    u32x4 w; w.x = cvt_pk_bf16(v0[0], v0[1]); w.y = cvt_pk_bf16(v0[2], v0[3]); w.z = cvt_pk_bf16(v1[0], v1[1]); w.w = cvt_pk_bf16(v1[2], v1[3]); __builtin_nontemporal_store(w, (EGAS u32x4*)dst); }
typedef unsigned u32x2e __attribute__((ext_vector_type(2)));
__device__ __forceinline__ void st8f8(EGAS unsigned char* dst, f32x4 v0, f32x4 v1) {
    int w0 = __builtin_amdgcn_cvt_pk_fp8_f32(v0[0], v0[1], 0, false); w0 = __builtin_amdgcn_cvt_pk_fp8_f32(v0[2], v0[3], w0, true);
    int w1 = __builtin_amdgcn_cvt_pk_fp8_f32(v1[0], v1[1], 0, false); w1 = __builtin_amdgcn_cvt_pk_fp8_f32(v1[2], v1[3], w1, true);
    *(EGAS u32x2e*)dst = (u32x2e){(unsigned)w0, (unsigned)w1}; }
#define WS8(off) ((EGAS unsigned char*)(p.ws + (off)))
__device__ __forceinline__ void ld8f8(const EGAS unsigned char* src, f32x4& v0, f32x4& v1) {
    typedef float f32x2g __attribute__((ext_vector_type(2)));
    const u32x2e w = *(const EGAS u32x2e*)src;
    const f32x2g a = __builtin_amdgcn_cvt_pk_f32_fp8((int)w.x, false), b = __builtin_amdgcn_cvt_pk_f32_fp8((int)w.x, true), c = __builtin_amdgcn_cvt_pk_f32_fp8((int)w.y, false), d = __builtin_amdgcn_cvt_pk_f32_fp8((int)w.y, true);
    v0 = (f32x4){a.x, a.y, b.x, b.y}; v1 = (f32x4){c.x, c.y, d.x, d.y}; }
__device__ __forceinline__ void ld8(const EGAS bf16_t* src, f32x4& v0, f32x4& v1) {
    const u32x4 w = *(const EGAS u32x4*)src;
    v0[0] = __uint_as_float(w.x << 16); v0[1] = __uint_as_float(w.x & 0xffff0000u); v0[2] = __uint_as_float(w.y << 16); v0[3] = __uint_as_float(w.y & 0xffff0000u);
    v1[0] = __uint_as_float(w.z << 16); v1[1] = __uint_as_float(w.z & 0xffff0000u); v1[2] = __uint_as_float(w.w << 16); v1[3] = __uint_as_float(w.w & 0xffff0000u); }
__device__ __forceinline__ void rope8(f32x4& v0, f32x4& v1, const EGAS float* tab) {
    const f32x4 c0 = *(const EGAS f32x4*)tab, c1 = *(const EGAS f32x4*)(tab + 4);
    f32x4 a, b;
    a[0] = v0[0] * c0[0] - v0[1] * c0[1]; a[1] = v0[1] * c0[0] + v0[0] * c0[1]; a[2] = v0[2] * c0[2] - v0[3] * c0[3]; a[3] = v0[3] * c0[2] + v0[2] * c0[3];
    b[0] = v1[0] * c1[0] - v1[1] * c1[1]; b[1] = v1[1] * c1[0] + v1[0] * c1[1]; b[2] = v1[2] * c1[2] - v1[3] * c1[3]; b[3] = v1[3] * c1[2] + v1[2] * c1[3];
    v0 = a; v1 = b; }
__device__ __forceinline__ float sigm(float x) { return __builtin_amdgcn_rcpf(1.f + __expf(-x)); }
template <int MODE> struct Epi {
    static constexpr bool PERM = true, AFTER_DRAIN = false;
    EpiP p;
    __device__ __forceinline__ void operator()(const f32x4 (&acc)[2][2][4][2], const Unit& u, int wr, int wc, int fr, int fq) const {
        const int row0 = u.pm * BM + wr * 64 + fr, pn = u.pn, cw = wc * 32 + 8 * fq;
        float rs[2][4];
#pragma unroll
        for (int ai = 0; ai < 2; ++ai)
#pragma unroll
            for (int m = 0; m < 4; ++m) rs[ai][m] = 1.f;
        if constexpr (MODE == EP_IN || MODE == EP_U) {
            const EGAS float* rsp = WSF(WS_RSTD) + row0;
#pragma unroll
            for (int ai = 0; ai < 2; ++ai)
#pragma unroll
                for (int m = 0; m < 4; ++m) rs[ai][m] = rsp[ai * HALF + m * 16];
        }
#pragma unroll
        for (int ai = 0; ai < 2; ++ai)
#pragma unroll
            for (int m = 0; m < 4; ++m) {
                const unsigned row = (unsigned)(row0 + ai * HALF + m * 16);
#pragma unroll
                for (int bj = 0; bj < 2; ++bj) {
                    f32x4 v0 = acc[ai][bj][m][0], v1 = acc[ai][bj][m][1];
                    if constexpr (MODE == EP_IN || MODE == EP_U) { v0 = v0 * rs[ai][m]; v1 = v1 * rs[ai][m]; }
                    const int ct = bj * HALF + cw;
                    if constexpr (MODE == EP_IN) {
                        if (pn < 12) {
                            rope8(v0, v1, WSF(WS_ROPEA) + (row * 64 + (cw >> 1)) * 2);
                            EGAS bf16_t* O = pn < 6 ? WSB(WS_QA) : WSB(WS_KA); const int c = (pn < 6 ? pn : pn - 6) * 256 + ct;
                            st8(O + row * WA + c, v0, v1);
                        } else if (pn < 18) { st8(WSB(WS_VA) + row * WA + (pn - 12) * 256 + ct, v0, v1);
                        } else if (pn < 20) { st8(WSB(WS_QL) + row * QLORA + (pn - 18) * 256 + ct, v0, v1);
                        } else if (pn < 22) { st8(WSB(WS_KVL) + row * KVLORA + (pn - 20) * 256 + ct, v0, v1);
                        } else if (pn < 38) {
                            const int gc = (pn - 22) * 256 + ct; const EGAS float* bg = (const EGAS float*)p.f0; const f32x4 b0 = *(const EGAS f32x4*)(bg + gc), b1 = *(const EGAS f32x4*)(bg + gc + 4);
#pragma unroll
                            for (int e = 0; e < 4; ++e) { v0[e] = sigm(v0[e] + b0[e]); v1[e] = sigm(v1[e] + b1[e]); }
                            st8f8(WS8(WS_GATES) + row * 4096 + gc, v0, v1);
                        } else {
                            if (bj == 0 && wc < 2) { rope8(v0, v1, WSF(WS_ROPEB) + (row * 32 + (cw >> 1)) * 2); st8f8(WS8(WS_KPE) + row * 64 + cw, v0, v1); }
                        }
                    } else if constexpr (MODE == EP_CQ) {
                        constexpr float QS = 8.f * 0.07216878364870323f * 1.4426950408889634f;
                        if (pn < 8) { st8f8(WS8(WS_QB) + row * 3072 + (pn * 2 + bj) * 192 + cw, v0 * QS, v1 * QS); }
                        else { const int head = (pn - 8) * 4 + bj * 2 + (wc >> 1), loc = (wc & 1) * 32 + 8 * fq;
                            rope8(v0, v1, WSF(WS_ROPEB) + (row * 32 + (loc >> 1)) * 2); st8f8(WS8(WS_QB) + row * 3072 + head * 192 + 128 + loc, v0 * QS, v1 * QS); }
                    } else if constexpr (MODE == EP_CKV) {
                        if (bj == 0) st8f8(WS8(WS_KN) + row * 2048 + pn * 128 + cw, v0, v1);
                        else {
                            const unsigned t = row >> 6, k5 = row & 31u, pos = ((k5 >> 2) & 1u) * 32u + ((row >> 5) & 1u) * 16u + ((k5 & 3u) | ((k5 >> 3) << 2));
                            EGAS unsigned char* vt = WS8(WS_VB) + ((size_t)(pn * (S_ / 64) + t) * 128 + cw) * 64 + pos;
                            const int w0 = __builtin_amdgcn_cvt_pk_fp8_f32(v0[0], v0[1], 0, false), w1 = __builtin_amdgcn_cvt_pk_fp8_f32(v0[2], v0[3], 0, false);
                            const int w2 = __builtin_amdgcn_cvt_pk_fp8_f32(v1[0], v1[1], 0, false), w3 = __builtin_amdgcn_cvt_pk_fp8_f32(v1[2], v1[3], 0, false);
                            vt[0] = (unsigned char)w0; vt[64] = (unsigned char)(w0 >> 8); vt[128] = (unsigned char)w1; vt[192] = (unsigned char)(w1 >> 8);
                            vt[256] = (unsigned char)w2; vt[320] = (unsigned char)(w2 >> 8); vt[384] = (unsigned char)w3; vt[448] = (unsigned char)(w3 >> 8); }
                    } else if constexpr (MODE == EP_YA) {
                        const int c = pn * 256 + ct; f32x4 g0, g1; ld8f8(WS8(WS_GATES) + row * 4096 + c, g0, g1);
                        st8(WSB(WS_T) + row * 2048 + c, v0 * g0, v1 * g1);
                    } else if constexpr (MODE == EP_YB) {
                        const int c = pn * 256 + ct; f32x4 g0, g1, t0, t1; ld8f8(WS8(WS_GATES) + row * 4096 + 2048 + c, g0, g1); ld8(WSB(WS_T) + row * 2048 + c, t0, t1);
                        st8(WSB(WS_MERGED) + row * 2048 + c, t0 + v0 * g0, t1 + v1 * g1);
                    } else if constexpr (MODE == EP_RES) {
                        const int c = pn * 256 + ct; EGAS bf16_t* xb = (EGAS bf16_t*)((EGAS unsigned char*)p.fo + 67108864) + row * 2048 + c; f32x4 x0, x1;
                        if (p.f0) { const EGAS float* xi = (const EGAS float*)p.f0 + row * 2048 + c; x0 = *(const EGAS f32x4*)xi; x1 = *(const EGAS f32x4*)(xi + 4); } else ld8(xb, x0, x1);
                        st8(xb, x0 + v0, x1 + v1);
                    } else {
                        st8nt(WSB(WS_U) + row * 11264 + pn * 256 + ct, v0, v1);
                    }
                }
            }
    }
};
template <class Epi, class Sched, bool ALIGN_EPI = false, bool SP2 = false>
__device__ __forceinline__ void gemm_phase(PG8_LAS unsigned char* lds, const Gemm g, const Sched& S, const Epi& E) {
    int tid_ = threadIdx.x; asm volatile("" : "+v"(tid_));
    const int tid = tid_, wid = __builtin_amdgcn_readfirstlane(tid >> 6), lane = tid & 63, wr = wid >> 2, wc = wid & 3, fr = lane & 15, fq = lane >> 4;
    const int K = g.K, nt = K / BK;
    unsigned voffA[2], voffB[2];
#pragma unroll
    for (int i = 0; i < 2; ++i) { int R, C; stage_rc(tid * 16 + i * 8192, R, C); const int Rb = Epi::PERM ? ((R & ~31) + perm32(R & 31)) : R;
        voffA[i] = (unsigned)(R * K + C) * 2u; voffB[i] = (unsigned)(Rb * K + C) * 2u; }
    const size_t kstep = (size_t)(BK * 2);
    const size_t hstep = (size_t)HALF * K * 2;
    const size_t tstep = 2 * hstep;
    const unsigned ldsw = (unsigned)wid * 1024u;
    const int aoff = lds_byte(wr * 64 + fr, fq * 8), boff = lds_byte(wc * 32 + fr, fq * 8);
#define PG8_SA(b, h) (((b) * 2 + (h)) * HTB)
#define PG8_SB(b, h) ((4 + (b) * 2 + (h)) * HTB)
#define PG8_STAGE(bufoff, gbase, voff) do { _Pragma("unroll") for (int _i = 0; _i < 2; ++_i) \
        __builtin_amdgcn_global_load_lds((const unsigned*)((const char*)(gbase) + (voff)[_i]), (PG8_LAS unsigned*)(lds + (bufoff) + ldsw + _i * 8192), 16, 0, 0); } while (0)
#define PG8_LDA(dst, b, h) do { _Pragma("unroll") for (int m = 0; m < 4; ++m) _Pragma("unroll") for (int k = 0; k < 2; ++k) dst[m][k] = *(const PG8_LAS bf16x8*)(lds + PG8_SA(b, h) + aoff + m * 2048 + k * 1024); } while (0)
#define PG8_LDB(dst, b, h) do { _Pragma("unroll") for (int n = 0; n < 2; ++n) _Pragma("unroll") for (int k = 0; k < 2; ++k) dst[n][k] = *(const PG8_LAS bf16x8*)(lds + PG8_SB(b, h) + boff + n * 2048 + k * 1024); } while (0)
#define PG8_MMA(ai, bj, At, Bt) do { __builtin_amdgcn_s_setprio(1); _Pragma("unroll") for (int m = 0; m < 4; ++m) _Pragma("unroll") for (int n = 0; n < 2; ++n) _Pragma("unroll") for (int k = 0; k < 2; ++k) \
        acc[ai][bj][m][n] = __builtin_amdgcn_mfma_f32_16x16x32_bf16(Bt[n][k], At[m][k], acc[ai][bj][m][n], 0, 0, 0); __builtin_amdgcn_s_setprio(0); } while (0)
#define PG8_WAIT_V(n) asm volatile("s_waitcnt vmcnt(" #n ")" ::: "memory")
#define PG8_WAIT_L(n) asm volatile("s_waitcnt lgkmcnt(" #n ")" ::: "memory")
#define PG8_BAR __builtin_amdgcn_s_barrier()
#define PG8_SCHED __builtin_amdgcn_sched_barrier(0)
    Unit cur, nxt; int ui = 0;
    if (!S.next(0, cur)) return;
    f32x4 acc[2][2][4][2];
#pragma unroll
    for (int a = 0; a < 2; ++a)
#pragma unroll
        for (int b = 0; b < 2; ++b)
#pragma unroll
            for (int m = 0; m < 4; ++m)
#pragma unroll
                for (int n = 0; n < 2; ++n) acc[a][b][m][n] = (f32x4){0.f, 0.f, 0.f, 0.f};
    bf16x8 At[4][2], B0[2][2], B1[2][2];
    const char* cA = (const char*)g.A + (size_t)cur.pm * tstep; const char* cB = (const char*)g.Bt + (size_t)cur.pn * tstep;
    S.a_ready(cur);
    if constexpr (SP2) {
        PG8_STAGE(PG8_SB(0, 0), cB, voffB); PG8_STAGE(PG8_SB(0, 1), cB + hstep, voffB); PG8_STAGE(PG8_SA(0, 0), cA, voffA); PG8_STAGE(PG8_SA(0, 1), cA + hstep, voffA);
        if (wr == 1) PG8_BAR;
        PG8_WAIT_V(2); PG8_BAR;
        PG8_STAGE(PG8_SB(1, 0), cB + kstep, voffB); PG8_STAGE(PG8_SA(1, 0), cA + kstep, voffA); PG8_STAGE(PG8_SB(1, 1), cB + hstep + kstep, voffB);
        PG8_WAIT_V(6); PG8_BAR;
    } else {
        PG8_STAGE(PG8_SB(0, 0), cB, voffB); PG8_STAGE(PG8_SA(0, 0), cA, voffA); PG8_STAGE(PG8_SB(0, 1), cB + hstep, voffB); PG8_STAGE(PG8_SA(0, 1), cA + hstep, voffA);
        if (wr == 1) PG8_BAR;
        PG8_WAIT_V(4); PG8_BAR;
        PG8_STAGE(PG8_SB(1, 0), cB + kstep, voffB); PG8_STAGE(PG8_SA(1, 0), cA + kstep, voffA); PG8_STAGE(PG8_SB(1, 1), cB + hstep + kstep, voffB);
        PG8_WAIT_V(6); PG8_BAR;
    }
    for (;;) {
        const bool has_next = S.next(ui + 1, nxt);
        const char* nA = has_next ? (const char*)g.A + (size_t)nxt.pm * tstep : cA; const char* nB = has_next ? (const char*)g.Bt + (size_t)nxt.pn * tstep : cB;
        for (int t = 0; t < nt; t += 2) {
            const bool last = (t == nt - 2);
            const char* a1 = cA + (size_t)(t + 1) * kstep;
            const char* a2 = last ? nA : cA + (size_t)(t + 2) * kstep; const char* b2 = last ? nB : cB + (size_t)(t + 2) * kstep;
            const char* a3 = a2 + kstep; const char* b3 = b2 + kstep;
            if (last && has_next) S.a_ready(nxt);
            if constexpr (SP2) {
            PG8_LDB(B0, 0, 0); PG8_LDB(B1, 0, 1); PG8_SCHED; PG8_LDA(At, 0, 0); PG8_STAGE(PG8_SA(1, 1), a1 + hstep, voffA);
            PG8_WAIT_V(8); PG8_WAIT_L(0); PG8_BAR; PG8_MMA(0, 0, At, B0); PG8_MMA(0, 1, At, B1); PG8_BAR; PG8_SCHED;
            PG8_LDA(At, 0, 1); PG8_STAGE(PG8_SB(0, 0), b2, voffB); PG8_STAGE(PG8_SB(0, 1), b2 + hstep, voffB); PG8_STAGE(PG8_SA(0, 0), a2, voffA);
            PG8_WAIT_V(8); PG8_WAIT_L(0); PG8_BAR; PG8_MMA(1, 0, At, B0); PG8_MMA(1, 1, At, B1); PG8_BAR; PG8_SCHED;
            PG8_LDB(B0, 1, 0); PG8_LDB(B1, 1, 1); PG8_SCHED; PG8_LDA(At, 1, 0); PG8_STAGE(PG8_SA(0, 1), a2 + hstep, voffA);
            PG8_WAIT_V(8); PG8_WAIT_L(0); PG8_BAR; PG8_MMA(0, 0, At, B0); PG8_MMA(0, 1, At, B1); PG8_BAR; PG8_SCHED;
            PG8_LDA(At, 1, 1); PG8_STAGE(PG8_SB(1, 0), b3, voffB); PG8_STAGE(PG8_SB(1, 1), b3 + hstep, voffB); PG8_STAGE(PG8_SA(1, 0), a3, voffA);
            PG8_WAIT_V(8); PG8_WAIT_L(0); PG8_BAR; PG8_MMA(1, 0, At, B0); PG8_MMA(1, 1, At, B1); PG8_BAR; PG8_SCHED;
            } else {
            PG8_LDB(B0, 0, 0); PG8_SCHED; PG8_LDA(At, 0, 0); PG8_STAGE(PG8_SA(1, 1), a1 + hstep, voffA);
            PG8_WAIT_L(8); PG8_BAR; PG8_WAIT_L(0); PG8_MMA(0, 0, At, B0); PG8_BAR; PG8_SCHED;
            PG8_LDB(B1, 0, 1); PG8_STAGE(PG8_SB(0, 0), b2, voffB);
            PG8_BAR; PG8_WAIT_L(0); PG8_MMA(0, 1, At, B1); PG8_BAR;
            PG8_LDA(At, 0, 1); PG8_STAGE(PG8_SA(0, 0), a2, voffA);
            PG8_BAR; PG8_WAIT_L(0); PG8_MMA(1, 0, At, B0); PG8_BAR; PG8_SCHED;
            PG8_STAGE(PG8_SB(0, 1), b2 + hstep, voffB);
            PG8_WAIT_V(6); PG8_BAR; PG8_MMA(1, 1, At, B1); PG8_BAR;
            PG8_LDB(B0, 1, 0); PG8_SCHED; PG8_LDA(At, 1, 0); PG8_STAGE(PG8_SA(0, 1), a2 + hstep, voffA);
            PG8_WAIT_L(8); PG8_BAR; PG8_WAIT_L(0); PG8_MMA(0, 0, At, B0); PG8_BAR; PG8_SCHED;
            PG8_LDB(B1, 1, 1); PG8_STAGE(PG8_SB(1, 0), b3, voffB);
            PG8_BAR; PG8_WAIT_L(0); PG8_MMA(0, 1, At, B1); PG8_BAR;
            PG8_LDA(At, 1, 1); PG8_STAGE(PG8_SA(1, 0), a3, voffA);
            PG8_BAR; PG8_WAIT_L(0); PG8_MMA(1, 0, At, B0); PG8_BAR; PG8_SCHED;
            PG8_STAGE(PG8_SB(1, 1), b3 + hstep, voffB);
            PG8_WAIT_V(6); PG8_BAR; PG8_MMA(1, 1, At, B1); PG8_BAR;
            }
        }
        if constexpr (ALIGN_EPI) { if (wr == 0) PG8_BAR; }
        if constexpr (!Epi::AFTER_DRAIN) { E(acc, cur, wr, wc, fr, fq); S.done(cur); }
        if (!has_next) break;
#pragma unroll
        for (int a = 0; a < 2; ++a)
#pragma unroll
            for (int b = 0; b < 2; ++b)
#pragma unroll
                for (int m = 0; m < 4; ++m)
#pragma unroll
                    for (int n = 0; n < 2; ++n) acc[a][b][m][n] = (f32x4){0.f, 0.f, 0.f, 0.f};
        cur = nxt; cA = nA; cB = nB; ++ui;
        if constexpr (ALIGN_EPI) { if (wr == 1) PG8_BAR; }
    }
    PG8_WAIT_V(0);
    if constexpr (!ALIGN_EPI) { if (wr == 0) PG8_BAR; }
    PG8_BAR;
    if constexpr (Epi::AFTER_DRAIN) { E.fused(acc, cur, wr, wc, fr, fq, lds, wid, lane); S.done(cur); }
#undef PG8_SA
#undef PG8_SB
#undef PG8_STAGE
#undef PG8_LDA
#undef PG8_LDB
#undef PG8_MMA
#undef PG8_WAIT_V
#undef PG8_WAIT_L
#undef PG8_BAR
#undef PG8_SCHED
}
}
namespace att {
typedef unsigned short bf16_t;
typedef short bf16x8 __attribute__((ext_vector_type(8)));
typedef short s16x4 __attribute__((ext_vector_type(4)));
typedef float f32x16 __attribute__((ext_vector_type(16)));
typedef unsigned u32x4 __attribute__((ext_vector_type(4)));
constexpr int SHM_V = 16384, SHM_K = 16384, SHM_KR = 8192;
constexpr int OFF_V = 0, OFF_K = 2 * SHM_V, OFF_KR = OFF_K + 2 * SHM_K, OFF_WS = OFF_KR + 2 * SHM_KR, ATT_LDS = OFF_WS + 8 * 64 * 4;
#ifndef ATT_SDEPTH
#define ATT_SDEPTH 2
#endif
constexpr int SDEPTH = ATT_SDEPTH;
#define KSWZ(row, colB) ((row) * 256 + ((colB) ^ (((row) & 15) << 4)))
#define KRSWZ(row, colB) ((row) * 128 + ((colB) ^ ((((row) >> 1) & 7) << 4)))
#define SBAR() __builtin_amdgcn_sched_barrier(0)
__device__ __forceinline__ int crow(int r, int hi) { return (r & 3) + 8 * (r >> 2) + 4 * hi; }
__device__ __forceinline__ unsigned cvtpk(float lo, float hi) { unsigned r; asm volatile("v_cvt_pk_bf16_f32 %0, %1, %2" : "=v"(r) : "v"(lo), "v"(hi)); return r; }

__device__ __forceinline__ void partialSM(f32x16& p0, f32x16& p1, float& m_reg, float& mn, float& alpha, const float C, const float thr_raw) {
  float pmax = p0[0];
#pragma unroll
  for (int r = 1; r < 16; ++r) pmax = fmaxf(pmax, p0[r]);
#pragma unroll
  for (int r = 0; r < 16; ++r) pmax = fmaxf(pmax, p1[r]);
  { auto rr = __builtin_amdgcn_permlane32_swap(__float_as_uint(pmax), __float_as_uint(pmax), false, false);
    pmax = fmaxf(__uint_as_float(rr[0]), __uint_as_float(rr[1])); }
  if (__builtin_expect(__all(pmax - m_reg <= thr_raw), 1)) { mn = m_reg; alpha = 1.f; }
  else { mn = fmaxf(m_reg, pmax); alpha = __builtin_amdgcn_exp2f((m_reg - mn) * C); m_reg = mn; }
  const float mnC = -mn * C;
#pragma unroll
  for (int r = 0; r < 16; ++r) p0[r] = fmaf(p0[r], C, mnC);
#pragma unroll
  for (int r = 0; r < 16; ++r) p1[r] = fmaf(p1[r], C, mnC);
#pragma unroll
  for (int r = 0; r < 16; ++r) p0[r] = __builtin_amdgcn_exp2f(p0[r]);
}
__device__ __forceinline__ void finishSM(f32x16& p0, f32x16& p1, float alpha, float& l_reg, bf16x8& pa0, bf16x8& pa1, bf16x8& pa2, bf16x8& pa3) {
#pragma unroll
  for (int r = 0; r < 16; ++r) p1[r] = __builtin_amdgcn_exp2f(p1[r]);
  float ps = 0;
#pragma unroll
  for (int r = 0; r < 16; ++r) ps += p0[r];
#pragma unroll
  for (int r = 0; r < 16; ++r) ps += p1[r];
  { auto rr = __builtin_amdgcn_permlane32_swap(__float_as_uint(ps), __float_as_uint(ps), false, false);
    ps = __uint_as_float(rr[0]) + __uint_as_float(rr[1]); }
  l_reg = l_reg * alpha + ps;
#define PK4(P, BASE, OUT) do { unsigned a0 = cvtpk(P[BASE + 0], P[BASE + 1]), a1 = cvtpk(P[BASE + 2], P[BASE + 3]);   \
    unsigned b0 = cvtpk(P[BASE + 4], P[BASE + 5]), b1 = cvtpk(P[BASE + 6], P[BASE + 7]);                              \
    auto r0 = __builtin_amdgcn_permlane32_swap(a0, b0, false, false); auto r1 = __builtin_amdgcn_permlane32_swap(a1, b1, false, false); \
    u32x4 w = {r0[0], r1[0], r0[1], r1[1]}; OUT = *reinterpret_cast<bf16x8*>(&w); } while (0)
  PK4(p0, 0, pa0); PK4(p0, 8, pa1); PK4(p1, 0, pa2); PK4(p1, 8, pa3);
#undef PK4
}
template <int NR>
__device__ __forceinline__ void qkt(f32x16& p0, f32x16& p1, const char* Ks, const char* Krs, const bf16x8* qr, int r32, int hi) {
  p0 = f32x16{}; p1 = f32x16{};
#pragma unroll
  for (int d0 = 0; d0 < 8; ++d0) { const int cb = (d0 * 16 + hi * 8) * 2;
    bf16x8 b0 = *reinterpret_cast<const bf16x8*>(Ks + KSWZ(r32, cb));
    bf16x8 b1 = *reinterpret_cast<const bf16x8*>(Ks + KSWZ(32 + r32, cb));
    p0 = __builtin_amdgcn_mfma_f32_32x32x16_bf16(b0, qr[d0], p0, 0, 0, 0);
    p1 = __builtin_amdgcn_mfma_f32_32x32x16_bf16(b1, qr[d0], p1, 0, 0, 0); if ((d0 & 3) == 3) SBAR(); }
#pragma unroll
  for (int d0 = 0; d0 < NR; ++d0) { const int cb = (d0 * 16 + hi * 8) * 2;
    bf16x8 b0 = *reinterpret_cast<const bf16x8*>(Krs + KRSWZ(r32, cb));
    bf16x8 b1 = *reinterpret_cast<const bf16x8*>(Krs + KRSWZ(32 + r32, cb));
    p0 = __builtin_amdgcn_mfma_f32_32x32x16_bf16(b0, qr[8 + d0], p0, 0, 0, 0);
    p1 = __builtin_amdgcn_mfma_f32_32x32x16_bf16(b1, qr[8 + d0], p1, 0, 0, 0); }
}
__device__ __forceinline__ void qkt_r(f32x16& p0, f32x16& p1, const char* Ks, const char* Krs, const bf16x8* qr, const char* qrl, int r32, int hi) {
  p0 = f32x16{}; p1 = f32x16{};
#pragma unroll
  for (int d0 = 0; d0 < 8; ++d0) { const int cb = (d0 * 16 + hi * 8) * 2;
    bf16x8 b0 = *reinterpret_cast<const bf16x8*>(Ks + KSWZ(r32, cb));
    bf16x8 b1 = *reinterpret_cast<const bf16x8*>(Ks + KSWZ(32 + r32, cb));
    p0 = __builtin_amdgcn_mfma_f32_32x32x16_bf16(b0, qr[d0], p0, 0, 0, 0);
    p1 = __builtin_amdgcn_mfma_f32_32x32x16_bf16(b1, qr[d0], p1, 0, 0, 0); }
#pragma unroll
  for (int d0 = 0; d0 < 4; ++d0) { const int cb = (d0 * 16 + hi * 8) * 2;
    bf16x8 b0 = *reinterpret_cast<const bf16x8*>(Krs + KRSWZ(r32, cb));
    bf16x8 b1 = *reinterpret_cast<const bf16x8*>(Krs + KRSWZ(32 + r32, cb));
    const bf16x8 q = *reinterpret_cast<const bf16x8*>(qrl + d0 * 1024);
    p0 = __builtin_amdgcn_mfma_f32_32x32x16_bf16(b0, q, p0, 0, 0, 0);
    p1 = __builtin_amdgcn_mfma_f32_32x32x16_bf16(b1, q, p1, 0, 0, 0); }
}
__device__ __forceinline__ void amask(f32x16& p0, f32x16& p1, int base) {
#pragma unroll
  for (int r = 0; r < 16; ++r) { const int d = base + (r & 3) + 8 * (r >> 2);
    if (d > 64 || d < -64) p0[r] = -30000.f;
    if (d + 32 > 64 || d + 32 < -64) p1[r] = -30000.f; }
}
__device__ __forceinline__ int v_st(int k, int c) { const int kk = (k & ~0xC) | ((k & 4) << 1) | ((k & 8) >> 1); return ((kk >> 3) * 4 + (c >> 5)) * 512 + ((kk & 7) * 32 + (c & 31)) * 2; }
__device__ __forceinline__ int v_rd_base(int lane) { return ((lane & 3) << 3) | (((lane >> 2) & 3) << 6) | (((lane >> 4) & 1) << 5) | (((lane >> 5) & 1) << 8); }
constexpr int v_rd_off(int d0, int ks, int half) { return d0 * 512 + ks * 4096 + half * 2048; }
template <int OFF> __device__ __forceinline__ s16x4 tr_read(int vb) {
  s16x4 r; asm volatile("ds_read_b64_tr_b16 %0, %1 offset:%2" : "=&v"(r) : "v"(vb), "i"(OFF) : "memory"); return r;
}
template <int D0> __device__ __forceinline__ void pv_one(f32x16& od, int vb, bf16x8 pa0, bf16x8 pa1, bf16x8 pa2, bf16x8 pa3) {
  const s16x4 l0 = tr_read<v_rd_off(D0, 0, 0)>(vb), h0 = tr_read<v_rd_off(D0, 0, 1)>(vb), l1 = tr_read<v_rd_off(D0, 1, 0)>(vb), h1 = tr_read<v_rd_off(D0, 1, 1)>(vb);
  const s16x4 l2 = tr_read<v_rd_off(D0, 2, 0)>(vb), h2 = tr_read<v_rd_off(D0, 2, 1)>(vb), l3 = tr_read<v_rd_off(D0, 3, 0)>(vb), h3 = tr_read<v_rd_off(D0, 3, 1)>(vb);
  asm volatile("s_waitcnt lgkmcnt(0)" ::: "memory"); SBAR();
#define PK(L, H) (bf16x8){L[0], L[1], L[2], L[3], H[0], H[1], H[2], H[3]}
  od = __builtin_amdgcn_mfma_f32_32x32x16_bf16(pa0, PK(l0, h0), od, 0, 0, 0);
  od = __builtin_amdgcn_mfma_f32_32x32x16_bf16(pa1, PK(l1, h1), od, 0, 0, 0);
  od = __builtin_amdgcn_mfma_f32_32x32x16_bf16(pa2, PK(l2, h2), od, 0, 0, 0);
  od = __builtin_amdgcn_mfma_f32_32x32x16_bf16(pa3, PK(l3, h3), od, 0, 0, 0);
#undef PK
}
__device__ __forceinline__ void pv_d0(f32x16* o, int vb, bf16x8 pa0, bf16x8 pa1, bf16x8 pa2, bf16x8 pa3) {
  pv_one<0>(o[0], vb, pa0, pa1, pa2, pa3); pv_one<1>(o[1], vb, pa0, pa1, pa2, pa3); pv_one<2>(o[2], vb, pa0, pa1, pa2, pa3); pv_one<3>(o[3], vb, pa0, pa1, pa2, pa3);
}
template <int NR, bool MASK>
__device__ __forceinline__ void attn_unit(const bf16_t* __restrict__ Qb, int ldq, const bf16_t* __restrict__ Kh, int ldk, const bf16_t* __restrict__ Krh,
                                          const bf16_t* __restrict__ Vh, int ldv, bf16_t* __restrict__ Ob, int ldo, float* __restrict__ lse, int ldlse,
                                          const int NT, const int qoff, const float C, const float thr_raw, const float scale, char* lds) {
  int tid_ = threadIdx.x; asm volatile("" : "+v"(tid_));
  const int tid = tid_, wid = __builtin_amdgcn_readfirstlane(tid >> 6), lane = tid & 63, r32 = lane & 31, hi = lane >> 5;
  char* V_lds = lds + OFF_V; char* K_lds = lds + OFF_K; char* Kr_lds = lds + OFF_KR;
  float* ws = (float*)(lds + OFF_WS) + wid * 64; float* li_l = ws; float* al_l = ws + 32;
  float m_reg = MASK ? -30000.f : -1e30f, l_reg = 0; f32x16 o[4] = {}; bf16x8 qr[8 + NR];
  { const bf16_t* Qw = Qb + (unsigned)((wid * 32 + r32) * ldq + hi * 8);
#pragma unroll
    for (int d0 = 0; d0 < 8 + NR; ++d0) qr[d0] = *reinterpret_cast<const bf16x8*>(Qw + d0 * 16); }
  const int sr = tid >> 4, sc = (tid & 15) * 8, vst0 = v_st(sr, sc), vst1 = v_st(32 + sr, sc);
  const int krr = tid >> 3, krc = tid & 7, krst = KRSWZ(krr, krc * 16);
  const int vb0 = (int)(uintptr_t)V_lds + v_rd_base(lane);
  const int mbase = 4 * hi - (qoff + wid * 32 + r32);
  unsigned voff = (unsigned)(sr * ldv + sc), koff = (unsigned)(sr * ldk + sc), kroff = (unsigned)(krr * 64 + krc * 8);
  bf16x8 vs0, vs1, ks0, ks1, kr;
#define SLOAD() do { vs0 = *(const bf16x8*)(Vh + voff); vs1 = *(const bf16x8*)(Vh + voff + 32u * (unsigned)ldv); \
    ks0 = *(const bf16x8*)(Kh + koff); ks1 = *(const bf16x8*)(Kh + koff + 32u * (unsigned)ldk); \
    if constexpr (NR > 0) { kr = *(const bf16x8*)(Krh + kroff); kroff += 64u * 64u; } voff += 64u * (unsigned)ldv; koff += 64u * (unsigned)ldk; } while (0)
#define SWRITE(b) do { *(bf16x8*)(V_lds + (b) * SHM_V + vst0) = vs0; *(bf16x8*)(V_lds + (b) * SHM_V + vst1) = vs1; const int kc = sc * 2;  \
    *(bf16x8*)(K_lds + (b) * SHM_K + KSWZ(sr, kc)) = ks0; *(bf16x8*)(K_lds + (b) * SHM_K + KSWZ(32 + sr, kc)) = ks1; \
    if constexpr (NR > 0) *(bf16x8*)(Kr_lds + (b) * SHM_KR + krst) = kr; } while (0)
  f32x16 p0, p1; float mn, al; bf16x8 pa0, pa1, pa2, pa3;
  SLOAD(); SWRITE(0); __syncthreads();
  for (int j = 0; j < NT; ++j) {
    const int b = j & 1;
    if (j + 1 < NT) SLOAD();
    SBAR();
    bool live = true;
    if constexpr (MASK) { const int qlo = qoff + wid * 32, klo = 64 * j; live = !(klo > qlo + 31 + 64 || klo + 63 < qlo - 64); }
    if (live) {
    qkt<NR>(p0, p1, K_lds + b * SHM_K, Kr_lds + b * SHM_KR, qr, r32, hi);
    if constexpr (MASK) amask(p0, p1, 64 * j + mbase);
    partialSM(p0, p1, m_reg, mn, al, C, thr_raw);
    if (__any(al < 1.f)) { if (hi == 0) al_l[r32] = al; asm volatile("s_waitcnt lgkmcnt(0)" ::: "memory");
#pragma unroll
      for (int d = 0; d < 4; ++d)
#pragma unroll
        for (int r = 0; r < 16; ++r) o[d][r] *= al_l[crow(r, hi)]; }
    finishSM(p0, p1, al, l_reg, pa0, pa1, pa2, pa3); SBAR();
    pv_d0(o, vb0 + b * SHM_V, pa0, pa1, pa2, pa3);
    }
    SBAR();
    if (j + 1 < NT) SWRITE(b ^ 1);
    __syncthreads();
  }
  if (hi == 0) li_l[r32] = l_reg; asm volatile("s_waitcnt lgkmcnt(0)" ::: "memory");
  bf16_t* Ow = Ob + (unsigned)(wid * 32 * ldo + r32);
#pragma unroll
  for (int r = 0; r < 16; ++r) { const int orow = crow(r, hi); const float rl = __builtin_amdgcn_rcpf(li_l[orow]);
#pragma unroll
    for (int d0 = 0; d0 < 4; ++d0) Ow[(unsigned)(orow * ldo + d0 * 32)] = (bf16_t)(cvtpk(o[d0][r] * rl, 0.f) & 0xffffu); }
  if constexpr (MASK) { if (hi == 0) lse[(unsigned)((wid * 32 + r32) * ldlse)] = m_reg * scale + __logf(l_reg); }
  __syncthreads();
#undef SLOAD
#undef SWRITE
}

__device__ __forceinline__ void fakeSM(f32x16& p0, f32x16& p1, bf16x8& pa0, bf16x8& pa1, bf16x8& pa2, bf16x8& pa3) {
#define PK4(P, BASE, OUT) do { unsigned a0 = cvtpk(P[BASE + 0], P[BASE + 1]), a1 = cvtpk(P[BASE + 2], P[BASE + 3]);   \
    unsigned b0 = cvtpk(P[BASE + 4], P[BASE + 5]), b1 = cvtpk(P[BASE + 6], P[BASE + 7]);                              \
    auto r0 = __builtin_amdgcn_permlane32_swap(a0, b0, false, false); auto r1 = __builtin_amdgcn_permlane32_swap(a1, b1, false, false); \
    u32x4 w = {r0[0], r1[0], r0[1], r1[1]}; OUT = *reinterpret_cast<bf16x8*>(&w); } while (0)
  PK4(p0, 0, pa0); PK4(p0, 8, pa1); PK4(p1, 0, pa2); PK4(p1, 8, pa3);
#undef PK4
}
__device__ __forceinline__ void qkt_fake(f32x16& p0, f32x16& p1, const bf16x8* qr) {
  p0 = f32x16{}; p1 = f32x16{};
#pragma unroll
  for (int d0 = 0; d0 < 12; ++d0) { p0 = __builtin_amdgcn_mfma_f32_32x32x16_bf16(qr[(d0 + 1) & 7], qr[d0 & 7], p0, 0, 0, 0); p1 = __builtin_amdgcn_mfma_f32_32x32x16_bf16(qr[(d0 + 2) & 7], qr[d0 & 7], p1, 0, 0, 0); }
}
__device__ __forceinline__ void pv_fake(f32x16* o, bf16x8 pa0, bf16x8 pa1, bf16x8 pa2, bf16x8 pa3) {
#pragma unroll
  for (int d = 0; d < 4; ++d) { o[d] = __builtin_amdgcn_mfma_f32_32x32x16_bf16(pa0, pa1, o[d], 0, 0, 0); o[d] = __builtin_amdgcn_mfma_f32_32x32x16_bf16(pa1, pa2, o[d], 0, 0, 0);
    o[d] = __builtin_amdgcn_mfma_f32_32x32x16_bf16(pa2, pa3, o[d], 0, 0, 0); o[d] = __builtin_amdgcn_mfma_f32_32x32x16_bf16(pa3, pa0, o[d], 0, 0, 0); }
}
template <int NR, int FAKE = 0>
__device__ __forceinline__ void attn_unit2(const bf16_t* __restrict__ Qb, int ldq, const bf16_t* __restrict__ Kh, int ldk, const bf16_t* __restrict__ Krh,
                                           const bf16_t* __restrict__ Vh, int ldv, bf16_t* __restrict__ Ob, int ldo, const int NT, const float C, const float thr_raw, char* lds) {
  int tid_ = threadIdx.x; asm volatile("" : "+v"(tid_));
  const int tid = tid_, wid = tid >> 6, lane = tid & 63, r32 = lane & 31, hi = lane >> 5;
  char* V_lds = lds + OFF_V; char* K_lds = lds + OFF_K; char* Kr_lds = lds + OFF_KR;
  float* ws = (float*)(lds + OFF_WS) + wid * 64; float* li_l = ws; float* al_l = ws + 32;
  float m_reg = -1e30f, l_reg = 0; f32x16 o[4] = {}; bf16x8 qr[8];
  char* qrl = lds + ATT_LDS + wid * 4096 + lane * 16;
  { const bf16_t* Qw = Qb + (unsigned)((wid * 32 + r32) * ldq + hi * 8);
#pragma unroll
    for (int d0 = 0; d0 < 8; ++d0) qr[d0] = *reinterpret_cast<const bf16x8*>(Qw + d0 * 16);
#pragma unroll
    for (int d0 = 0; d0 < 4; ++d0) *reinterpret_cast<bf16x8*>(qrl + d0 * 1024) = *reinterpret_cast<const bf16x8*>(Qw + (8 + d0) * 16); }
  const int sr = tid >> 4, sc = (tid & 15) * 8, vst0 = v_st(sr, sc), kst0 = KSWZ(sr, sc * 2);
  const int krr = tid >> 3, krc = tid & 7, krst = KRSWZ(krr, krc * 16);
  const int vb0 = (int)(uintptr_t)V_lds + v_rd_base(lane);
  unsigned voff = (unsigned)(sr * ldv + sc), kroff = (unsigned)(krr * 64 + krc * 8);
  bf16x8 vs0, vs1, ks0, ks1, kr;
#define SLOAD() do { vs0 = *(const bf16x8*)(Vh + voff); vs1 = *(const bf16x8*)(Vh + voff + 32u * (unsigned)ldv); \
    ks0 = *(const bf16x8*)(Kh + voff); ks1 = *(const bf16x8*)(Kh + voff + 32u * (unsigned)ldv); \
    if constexpr (NR > 0) { kr = *(const bf16x8*)(Krh + kroff); kroff += 64u * 64u; } voff += 64u * (unsigned)ldv; } while (0)
#define SWRITE(b) do { *(bf16x8*)(V_lds + (b) * SHM_V + vst0) = vs0; *(bf16x8*)(V_lds + (b) * SHM_V + vst0 + 8192) = vs1;  \
    *(bf16x8*)(K_lds + (b) * SHM_K + kst0) = ks0; *(bf16x8*)(K_lds + (b) * SHM_K + kst0 + 8192) = ks1; \
    if constexpr (NR > 0) *(bf16x8*)(Kr_lds + (b) * SHM_KR + krst) = kr; } while (0)
#define RESC(a) do { if (__any((a) < 1.f)) { if (hi == 0) al_l[r32] = (a); asm volatile("s_waitcnt lgkmcnt(0)" ::: "memory"); \
    _Pragma("unroll") for (int d = 0; d < 4; ++d) _Pragma("unroll") for (int r = 0; r < 16; ++r) o[d][r] *= al_l[crow(r, hi)]; } } while (0)
  f32x16 pA0, pA1, pB0, pB1; float mnA, mnB, alA = 1.f, alB = 1.f; bf16x8 pa0, pa1, pa2, pa3;
#define QKT_A(K, KR) do { if constexpr (FAKE >= 2) qkt_fake(pA0, pA1, qr); else qkt_r(pA0, pA1, K, KR, qr, qrl, r32, hi); } while (0)
#define QKT_B(K, KR) do { if constexpr (FAKE >= 2) qkt_fake(pB0, pB1, qr); else qkt_r(pB0, pB1, K, KR, qr, qrl, r32, hi); } while (0)
#define PSM(P0, P1, MN, AL) do { if constexpr (FAKE == 0) partialSM(P0, P1, m_reg, MN, AL, C, thr_raw); } while (0)
#define FSM(P0, P1, AL) do { if constexpr (FAKE == 0) finishSM(P0, P1, AL, l_reg, pa0, pa1, pa2, pa3); else fakeSM(P0, P1, pa0, pa1, pa2, pa3); } while (0)
#define PVD(VB) do { if constexpr (FAKE >= 3) pv_fake(o, pa0, pa1, pa2, pa3); else pv_d0(o, VB, pa0, pa1, pa2, pa3); } while (0)
  SLOAD(); SWRITE(0); __syncthreads();
  SLOAD();
  QKT_A(K_lds, Kr_lds); PSM(pA0, pA1, mnA, alA);
  SWRITE(1); __syncthreads();
  for (int j = 1; j + 1 < NT; j += 2) {
    SLOAD(); SBAR();
    QKT_B(K_lds + SHM_K, Kr_lds + SHM_KR);
    FSM(pA0, pA1, alA); SBAR();
    PVD(vb0); PSM(pB0, pB1, mnB, alB);
    __syncthreads(); SWRITE(0);
    RESC(alB); __syncthreads();
    if (j + 2 < NT) SLOAD();
    SBAR();
    QKT_A(K_lds, Kr_lds);
    FSM(pB0, pB1, alB); SBAR();
    PVD(vb0 + SHM_V); PSM(pA0, pA1, mnA, alA);
    __syncthreads(); if (j + 2 < NT) SWRITE(1);
    RESC(alA); __syncthreads();
  }
  SBAR(); QKT_B(K_lds + SHM_K, Kr_lds + SHM_KR);
  FSM(pA0, pA1, alA); SBAR();
  PVD(vb0); PSM(pB0, pB1, mnB, alB);
  RESC(alB);
  FSM(pB0, pB1, alB); SBAR();
  PVD(vb0 + SHM_V);
  if constexpr (FAKE != 0) l_reg = 1.f;
  if (hi == 0) li_l[r32] = l_reg; asm volatile("s_waitcnt lgkmcnt(0)" ::: "memory");
  bf16_t* Ow = Ob + (unsigned)(wid * 32 * ldo + r32);
#pragma unroll
  for (int r = 0; r < 16; ++r) { const int orow = crow(r, hi); const float rl = __builtin_amdgcn_rcpf(li_l[orow]);
#pragma unroll
    for (int d0 = 0; d0 < 4; ++d0) Ow[(unsigned)(orow * ldo + d0 * 32)] = (bf16_t)(cvtpk(o[d0][r] * rl, 0.f) & 0xffffu); }
  __syncthreads();
#undef SLOAD
#undef SWRITE
#undef RESC
#undef QKT_A
#undef QKT_B
#undef PSM
#undef FSM
#undef PVD
}
typedef int v8i32 __attribute__((ext_vector_type(8)));
typedef int v4i32 __attribute__((ext_vector_type(4)));
constexpr int F8_V = 0, F8_KN = 2 * 16384, F8_KR = F8_KN + 2 * 8192, F8_WS = F8_KR + 2 * 4096, F8_LDS = F8_WS + 8 * 64 * 4;
#define KN8SW(row, chunk) ((row) * 128 + ((((chunk)) ^ (((row) >> 1) & 7)) << 4))
#define KR8SW(row, chunk) ((row) * 64 + ((((chunk)) ^ (((row) >> 2) & 3)) << 4))
__device__ __forceinline__ v8i32 cat8(v4i32 a, v4i32 b) { return (v8i32){a[0], a[1], a[2], a[3], b[0], b[1], b[2], b[3]}; }
__device__ __forceinline__ void qkt8(f32x16& p0, f32x16& p1, const char* Kn, const char* Kr, const v8i32* qf, int r32, int hi) {
  p0 = f32x16{}; p1 = f32x16{};
#pragma unroll
  for (int s = 0; s < 2; ++s) { const int c0 = s * 4 + hi * 2;
    const v8i32 a0 = cat8(*reinterpret_cast<const v4i32*>(Kn + KN8SW(r32, c0)), *reinterpret_cast<const v4i32*>(Kn + KN8SW(r32, c0 + 1)));
    const v8i32 a1 = cat8(*reinterpret_cast<const v4i32*>(Kn + 4096 + KN8SW(r32, c0)), *reinterpret_cast<const v4i32*>(Kn + 4096 + KN8SW(r32, c0 + 1)));
    p0 = __builtin_amdgcn_mfma_scale_f32_32x32x64_f8f6f4(a0, qf[s], p0, 0, 0, 0, 127, 0, 127);
    p1 = __builtin_amdgcn_mfma_scale_f32_32x32x64_f8f6f4(a1, qf[s], p1, 0, 0, 0, 127, 0, 127); }
  { const int c0 = hi * 2;
    const v8i32 a0 = cat8(*reinterpret_cast<const v4i32*>(Kr + KR8SW(r32, c0)), *reinterpret_cast<const v4i32*>(Kr + KR8SW(r32, c0 + 1)));
    const v8i32 a1 = cat8(*reinterpret_cast<const v4i32*>(Kr + 2048 + KR8SW(r32, c0)), *reinterpret_cast<const v4i32*>(Kr + 2048 + KR8SW(r32, c0 + 1)));
    p0 = __builtin_amdgcn_mfma_scale_f32_32x32x64_f8f6f4(a0, qf[2], p0, 0, 0, 0, 127, 0, 127);
    p1 = __builtin_amdgcn_mfma_scale_f32_32x32x64_f8f6f4(a1, qf[2], p1, 0, 0, 0, 127, 0, 127); }
}
__device__ __forceinline__ void attn_unit6(const unsigned char* __restrict__ Q8, int ldq, const unsigned char* __restrict__ Kn8, int ldk, const unsigned char* __restrict__ Kr8,
                                           const bf16_t* __restrict__ Vh, int ldv, bf16_t* __restrict__ Ob, int ldo, const int NT, const float C, const float thr_raw, char* lds) {
  int tid_ = threadIdx.x; asm volatile("" : "+v"(tid_));
  const int tid = tid_, wid = tid >> 6, lane = tid & 63, r32 = lane & 31, hi = lane >> 5;
  char* V_lds = lds + F8_V; char* Kn_lds = lds + F8_KN; char* Kr_lds = lds + F8_KR;
  float* ws = (float*)(lds + F8_WS) + wid * 64; float* li_l = ws; float* al_l = ws + 32;
  float m_reg = -1e30f, l_reg = 0; f32x16 o[4] = {}; v8i32 qf[3];
  { const unsigned char* Qw = Q8 + (unsigned)((wid * 32 + r32) * ldq + hi * 32);
#pragma unroll
    for (int s = 0; s < 3; ++s) qf[s] = cat8(*reinterpret_cast<const v4i32*>(Qw + s * 64), *reinterpret_cast<const v4i32*>(Qw + s * 64 + 16)); }
  const int sr = tid >> 4, sc = (tid & 15) * 8, vst0 = v_st(sr, sc);
  const int knr = tid >> 3, knc = tid & 7, knst = KN8SW(knr, knc);
  const int krr = (tid >> 2) & 63, krc = tid & 3, krst = KR8SW(krr, krc);
  const bool krw = tid < 256;
  const int vb0 = (int)(uintptr_t)V_lds + v_rd_base(lane);
  unsigned voff = (unsigned)(sr * ldv + sc), knoff = (unsigned)(knr * ldk + knc * 16), kroff = (unsigned)(krr * 64 + krc * 16);
  bf16x8 vs0, vs1; v4i32 kn, kr;
#define SLOAD() do { vs0 = *(const bf16x8*)(Vh + voff); vs1 = *(const bf16x8*)(Vh + voff + 32u * (unsigned)ldv); kn = *(const v4i32*)(Kn8 + knoff); \
    if (krw) kr = *(const v4i32*)(Kr8 + kroff); voff += 64u * (unsigned)ldv; knoff += 64u * (unsigned)ldk; kroff += 64u * 64u; } while (0)
#define SWRITE(b) do { *(bf16x8*)(V_lds + (b) * 16384 + vst0) = vs0; *(bf16x8*)(V_lds + (b) * 16384 + vst0 + 8192) = vs1;  \
    *(v4i32*)(Kn_lds + (b) * 8192 + knst) = kn; if (krw) *(v4i32*)(Kr_lds + (b) * 4096 + krst) = kr; } while (0)
#define RESC(a) do { if (__any((a) < 1.f)) { if (hi == 0) al_l[r32] = (a); asm volatile("s_waitcnt lgkmcnt(0)" ::: "memory"); \
    _Pragma("unroll") for (int d = 0; d < 4; ++d) _Pragma("unroll") for (int r = 0; r < 16; ++r) o[d][r] *= al_l[crow(r, hi)]; } } while (0)
  f32x16 pA0, pA1, pB0, pB1; float mnA, mnB, alA, alB; bf16x8 pa0, pa1, pa2, pa3;
  SLOAD(); SWRITE(0); __syncthreads();
  SLOAD();
  qkt8(pA0, pA1, Kn_lds, Kr_lds, qf, r32, hi); partialSM(pA0, pA1, m_reg, mnA, alA, C, thr_raw);
  SWRITE(1); __syncthreads();
  for (int j = 1; j + 1 < NT; j += 2) {
    SLOAD(); SBAR();
    qkt8(pB0, pB1, Kn_lds + 8192, Kr_lds + 4096, qf, r32, hi);
    finishSM(pA0, pA1, alA, l_reg, pa0, pa1, pa2, pa3); SBAR();
    pv_d0(o, vb0, pa0, pa1, pa2, pa3); partialSM(pB0, pB1, m_reg, mnB, alB, C, thr_raw);
    __syncthreads(); SWRITE(0);
    RESC(alB); __syncthreads();
    if (j + 2 < NT) SLOAD();
    SBAR();
    qkt8(pA0, pA1, Kn_lds, Kr_lds, qf, r32, hi);
    finishSM(pB0, pB1, alB, l_reg, pa0, pa1, pa2, pa3); SBAR();
    pv_d0(o, vb0 + 16384, pa0, pa1, pa2, pa3); partialSM(pA0, pA1, m_reg, mnA, alA, C, thr_raw);
    __syncthreads(); if (j + 2 < NT) SWRITE(1);
    RESC(alA); __syncthreads();
  }
  SBAR(); qkt8(pB0, pB1, Kn_lds + 8192, Kr_lds + 4096, qf, r32, hi);
  finishSM(pA0, pA1, alA, l_reg, pa0, pa1, pa2, pa3); SBAR();
  pv_d0(o, vb0, pa0, pa1, pa2, pa3); partialSM(pB0, pB1, m_reg, mnB, alB, C, thr_raw);
  RESC(alB);
  finishSM(pB0, pB1, alB, l_reg, pa0, pa1, pa2, pa3); SBAR();
  pv_d0(o, vb0 + 16384, pa0, pa1, pa2, pa3);
  if (hi == 0) li_l[r32] = l_reg; asm volatile("s_waitcnt lgkmcnt(0)" ::: "memory");
  bf16_t* Ow = Ob + (unsigned)(wid * 32 * ldo + r32);
#pragma unroll
  for (int r = 0; r < 16; ++r) { const int orow = crow(r, hi); const float rl = __builtin_amdgcn_rcpf(li_l[orow]);
#pragma unroll
    for (int d0 = 0; d0 < 4; ++d0) Ow[(unsigned)(orow * ldo + d0 * 32)] = (bf16_t)(cvtpk(o[d0][r] * rl, 0.f) & 0xffffu); }
  __syncthreads();
#undef SLOAD
#undef SWRITE
#undef RESC
}
constexpr int G8_VT = 0, G8_KN = 2 * 8192, G8_KR = G8_KN + 2 * 8192, G8_WS = G8_KR + 2 * 4096, G8_LDS = G8_WS + 8 * 64 * 4;
__device__ __forceinline__ void partialSM8(f32x16& p0, f32x16& p1, float& m_reg, float& alpha, const float C, const float thr_raw) {
  float pmax = p0[0];
#pragma unroll
  for (int r = 1; r < 16; ++r) pmax = fmaxf(pmax, p0[r]);
#pragma unroll
  for (int r = 0; r < 16; ++r) pmax = fmaxf(pmax, p1[r]);
  { auto rr = __builtin_amdgcn_permlane32_swap(__float_as_uint(pmax), __float_as_uint(pmax), false, false);
    pmax = fmaxf(__uint_as_float(rr[0]), __uint_as_float(rr[1])); }
  float mn;
  if (__builtin_expect(__all(pmax - m_reg <= thr_raw), 1)) { mn = m_reg; alpha = 1.f; }
  else { mn = fmaxf(m_reg, pmax); alpha = __builtin_amdgcn_exp2f((m_reg - mn) * C); m_reg = mn; }
  const float mnC = 7.0f - mn * C;
#pragma unroll
  for (int r = 0; r < 16; ++r) p0[r] = fmaf(p0[r], C, mnC);
#pragma unroll
  for (int r = 0; r < 16; ++r) p1[r] = fmaf(p1[r], C, mnC);
#pragma unroll
  for (int r = 0; r < 16; ++r) p0[r] = __builtin_amdgcn_exp2f(p0[r]);
}
__device__ __forceinline__ void finishSM8(f32x16& p0, f32x16& p1, float alpha, float& l_reg, v8i32& p8) {
#pragma unroll
  for (int r = 0; r < 16; ++r) p1[r] = __builtin_amdgcn_exp2f(p1[r]);
  float ps = 0;
#pragma unroll
  for (int r = 0; r < 16; ++r) ps += p0[r];
#pragma unroll
  for (int r = 0; r < 16; ++r) ps += p1[r];
  { auto rr = __builtin_amdgcn_permlane32_swap(__float_as_uint(ps), __float_as_uint(ps), false, false);
    ps = __uint_as_float(rr[0]) + __uint_as_float(rr[1]); }
  l_reg = l_reg * alpha + ps;
#pragma unroll
  for (int g = 0; g < 4; ++g) {
    int w = __builtin_amdgcn_cvt_pk_fp8_f32(p0[4 * g], p0[4 * g + 1], 0, false); p8[g] = __builtin_amdgcn_cvt_pk_fp8_f32(p0[4 * g + 2], p0[4 * g + 3], w, true);
    int u = __builtin_amdgcn_cvt_pk_fp8_f32(p1[4 * g], p1[4 * g + 1], 0, false); p8[4 + g] = __builtin_amdgcn_cvt_pk_fp8_f32(p1[4 * g + 2], p1[4 * g + 3], u, true); }
}
__device__ __forceinline__ void finishSM9(f32x16& p0, f32x16& p1, float alpha, float& l_reg, v8i32& p8) {
#pragma unroll
  for (int r = 0; r < 16; ++r) { p0[r] = __builtin_amdgcn_exp2f(p0[r]); p1[r] = __builtin_amdgcn_exp2f(p1[r]); }
  float ps = 0;
#pragma unroll
  for (int r = 0; r < 16; ++r) ps += p0[r];
#pragma unroll
  for (int r = 0; r < 16; ++r) ps += p1[r];
  { auto rr = __builtin_amdgcn_permlane32_swap(__float_as_uint(ps), __float_as_uint(ps), false, false);
    ps = __uint_as_float(rr[0]) + __uint_as_float(rr[1]); }
  l_reg = l_reg * alpha + ps;
#pragma unroll
  for (int g = 0; g < 4; ++g) {
    int w = __builtin_amdgcn_cvt_pk_fp8_f32(p0[4 * g], p0[4 * g + 1], 0, false); p8[g] = __builtin_amdgcn_cvt_pk_fp8_f32(p0[4 * g + 2], p0[4 * g + 3], w, true);
    int u = __builtin_amdgcn_cvt_pk_fp8_f32(p1[4 * g], p1[4 * g + 1], 0, false); p8[4 + g] = __builtin_amdgcn_cvt_pk_fp8_f32(p1[4 * g + 2], p1[4 * g + 3], u, true); }
}
__device__ __forceinline__ void pv8(f32x16* o, const char* Vt, const v8i32 p8, int r32, int hi) {
  const int sw = (r32 >> 2) & 3, a0 = r32 * 64 + (((hi * 2) ^ sw) << 4), a1 = r32 * 64 + (((hi * 2 + 1) ^ sw) << 4);
#pragma unroll
  for (int d0 = 0; d0 < 4; ++d0) {
    const v8i32 vf = cat8(*reinterpret_cast<const v4i32*>(Vt + d0 * 2048 + a0), *reinterpret_cast<const v4i32*>(Vt + d0 * 2048 + a1));
    o[d0] = __builtin_amdgcn_mfma_scale_f32_32x32x64_f8f6f4(p8, vf, o[d0], 0, 0, 0, 127, 0, 127); }
}
__device__ __forceinline__ void qkt9(f32x16& p0, f32x16& p1, const char* Kn, const char* Kr, const v8i32* qf, const float init, int r32, int hi) {
#pragma unroll
  for (int r = 0; r < 16; ++r) { p0[r] = init; p1[r] = init; }
#pragma unroll
  for (int s = 0; s < 2; ++s) { const int c0 = s * 4 + hi * 2;
    const v8i32 a0 = cat8(*reinterpret_cast<const v4i32*>(Kn + KN8SW(r32, c0)), *reinterpret_cast<const v4i32*>(Kn + KN8SW(r32, c0 + 1)));
    const v8i32 a1 = cat8(*reinterpret_cast<const v4i32*>(Kn + 4096 + KN8SW(r32, c0)), *reinterpret_cast<const v4i32*>(Kn + 4096 + KN8SW(r32, c0 + 1)));
    p0 = __builtin_amdgcn_mfma_scale_f32_32x32x64_f8f6f4(a0, qf[s], p0, 0, 0, 0, 127, 0, 124);
    p1 = __builtin_amdgcn_mfma_scale_f32_32x32x64_f8f6f4(a1, qf[s], p1, 0, 0, 0, 127, 0, 124); }
  { const int c0 = hi * 2;
    const v8i32 a0 = cat8(*reinterpret_cast<const v4i32*>(Kr + KR8SW(r32, c0)), *reinterpret_cast<const v4i32*>(Kr + KR8SW(r32, c0 + 1)));
    const v8i32 a1 = cat8(*reinterpret_cast<const v4i32*>(Kr + 2048 + KR8SW(r32, c0)), *reinterpret_cast<const v4i32*>(Kr + 2048 + KR8SW(r32, c0 + 1)));
    p0 = __builtin_amdgcn_mfma_scale_f32_32x32x64_f8f6f4(a0, qf[2], p0, 0, 0, 0, 127, 0, 124);
    p1 = __builtin_amdgcn_mfma_scale_f32_32x32x64_f8f6f4(a1, qf[2], p1, 0, 0, 0, 127, 0, 124); }
}
__device__ __forceinline__ void partialSM9(f32x16& p0, f32x16& p1, float& m_run, float& alpha, const float thr2) {
  float pmax = p0[0];
#pragma unroll
  for (int r = 1; r < 16; ++r) pmax = fmaxf(pmax, p0[r]);
#pragma unroll
  for (int r = 0; r < 16; ++r) pmax = fmaxf(pmax, p1[r]);
  { auto rr = __builtin_amdgcn_permlane32_swap(__float_as_uint(pmax), __float_as_uint(pmax), false, false);
    pmax = fmaxf(__uint_as_float(rr[0]), __uint_as_float(rr[1])); }
  if (__builtin_expect(__all(pmax <= 7.0f + thr2), 1)) { alpha = 1.f; }
  else { const float delta = fmaxf(pmax - 7.0f, 0.f); alpha = __builtin_amdgcn_exp2f(-delta); m_run += delta;
#pragma unroll
    for (int r = 0; r < 16; ++r) { p0[r] -= delta; p1[r] -= delta; } }
}
__device__ __forceinline__ void attn_unit7(const unsigned char* __restrict__ Q8, int ldq, const unsigned char* __restrict__ Kn8, int ldk, const unsigned char* __restrict__ Kr8,
                                           const unsigned char* __restrict__ VT8, bf16_t* __restrict__ Ob, int ldo, const int NT, const float C, const float thr_raw, char* lds) {
  int tid_ = threadIdx.x; asm volatile("" : "+v"(tid_));
  const int tid = tid_, wid = tid >> 6, lane = tid & 63, r32 = lane & 31, hi = lane >> 5;
  char* Vt_lds = lds + G8_VT; char* Kn_lds = lds + G8_KN; char* Kr_lds = lds + G8_KR;
  float* ws = (float*)(lds + G8_WS) + wid * 64; float* li_l = ws; float* al_l = ws + 32;
  float m_reg = 0.f, l_reg = 0; f32x16 o[4] = {}; v8i32 qf[3];
  { const unsigned char* Qw = Q8 + (unsigned)((wid * 32 + r32) * ldq + hi * 32);
#pragma unroll
    for (int s = 0; s < 3; ++s) qf[s] = cat8(*reinterpret_cast<const v4i32*>(Qw + s * 64), *reinterpret_cast<const v4i32*>(Qw + s * 64 + 16)); }
  const int vtr = tid >> 2, vtc = tid & 3, vtst = vtr * 64 + ((vtc ^ ((vtr >> 2) & 3)) << 4);
  const int knr = tid >> 3, knc = tid & 7, knst = KN8SW(knr, knc);
  const int krr = (tid >> 2) & 63, krc = tid & 3, krst = KR8SW(krr, krc);
  const bool krw = tid < 256;
  unsigned vtoff = (unsigned)(tid * 16), knoff = (unsigned)(knr * ldk + knc * 16), kroff = (unsigned)(krr * 64 + krc * 16);
  v4i32 vt, kn, kr;
#define SLOAD() do { vt = *(const v4i32*)(VT8 + vtoff); kn = *(const v4i32*)(Kn8 + knoff); if (krw) kr = *(const v4i32*)(Kr8 + kroff); \
    vtoff += 8192u; knoff += 64u * (unsigned)ldk; kroff += 64u * 64u; } while (0)
#define SWRITE(b) do { *(v4i32*)(Vt_lds + (b) * 8192 + vtst) = vt; *(v4i32*)(Kn_lds + (b) * 8192 + knst) = kn; if (krw) *(v4i32*)(Kr_lds + (b) * 4096 + krst) = kr; } while (0)
#define RESC(a) do { if (__any((a) < 1.f)) { if (hi == 0) al_l[r32] = (a); asm volatile("s_waitcnt lgkmcnt(0)" ::: "memory"); \
    _Pragma("unroll") for (int d = 0; d < 4; ++d) _Pragma("unroll") for (int r = 0; r < 16; ++r) o[d][r] *= al_l[crow(r, hi)]; } } while (0)
  f32x16 pA0, pA1, pB0, pB1; float alA, alB; v8i32 p8;
  SLOAD(); SWRITE(0); __syncthreads();
  SLOAD();
  qkt9(pA0, pA1, Kn_lds, Kr_lds, qf, 7.0f - m_reg, r32, hi); partialSM9(pA0, pA1, m_reg, alA, thr_raw);
  SWRITE(1); __syncthreads();
  for (int j = 1; j + 1 < NT; j += 2) {
    SLOAD();
    qkt9(pB0, pB1, Kn_lds + 8192, Kr_lds + 4096, qf, 7.0f - m_reg, r32, hi);
    finishSM9(pA0, pA1, alA, l_reg, p8);
    pv8(o, Vt_lds, p8, r32, hi); partialSM9(pB0, pB1, m_reg, alB, thr_raw);
    __syncthreads(); SWRITE(0);
    RESC(alB); __syncthreads();
    if (j + 2 < NT) SLOAD();

    qkt9(pA0, pA1, Kn_lds, Kr_lds, qf, 7.0f - m_reg, r32, hi);
    finishSM9(pB0, pB1, alB, l_reg, p8);
    pv8(o, Vt_lds + 8192, p8, r32, hi); partialSM9(pA0, pA1, m_reg, alA, thr_raw);
    __syncthreads(); if (j + 2 < NT) SWRITE(1);
    RESC(alA); __syncthreads();
  }
  qkt9(pB0, pB1, Kn_lds + 8192, Kr_lds + 4096, qf, 7.0f - m_reg, r32, hi);
  finishSM9(pA0, pA1, alA, l_reg, p8);
  pv8(o, Vt_lds, p8, r32, hi); partialSM9(pB0, pB1, m_reg, alB, thr_raw);
  RESC(alB);
  finishSM9(pB0, pB1, alB, l_reg, p8);
  pv8(o, Vt_lds + 8192, p8, r32, hi);
  if (hi == 0) li_l[r32] = l_reg; asm volatile("s_waitcnt lgkmcnt(0)" ::: "memory");
  char* ost = lds + G8_LDS + wid * 8192;
#pragma unroll
  for (int r = 0; r < 16; ++r) { const int orow = crow(r, hi); const float rl = __builtin_amdgcn_rcpf(li_l[orow]);
#pragma unroll
    for (int d0 = 0; d0 < 4; ++d0) *(bf16_t*)(ost + orow * 256 + (d0 * 32 + r32) * 2) = (bf16_t)(cvtpk(o[d0][r] * rl, 0.f) & 0xffffu); }
  asm volatile("s_waitcnt lgkmcnt(0)" ::: "memory");
  { bf16_t* Og = Ob + (unsigned)(wid * 32 * ldo);
#pragma unroll
    for (int i = 0; i < 8; ++i) { const int q = i * 64 + lane, row = q >> 4, c16 = q & 15;
      *(u32x4*)(Og + (unsigned)(row * ldo + c16 * 8)) = *(const u32x4*)(ost + row * 256 + c16 * 16); } }
  __syncthreads();
#undef SLOAD
#undef SWRITE
#undef RESC
}
#define ALAS __attribute__((address_space(3)))
constexpr int R_K = 0, R_V = 3 * 16384, R_KR = 6 * 16384, R_WS = R_KR + 3 * 8192, ATT3_LDS = R_WS + 8 * 64 * 4;
__device__ __forceinline__ void attn_unit3(const bf16_t* __restrict__ Qb, int ldq, const bf16_t* __restrict__ Kh, const bf16_t* __restrict__ Krh, const bf16_t* __restrict__ Vh, int ldkv,
                                           bf16_t* __restrict__ Ob, int ldo, const int NT, const float C, const float thr_raw, ALAS char* lds) {
  int tid_ = threadIdx.x; asm volatile("" : "+v"(tid_));
  const int tid = tid_, wid = __builtin_amdgcn_readfirstlane(tid >> 6), lane = tid & 63, r32 = lane & 31, hi = lane >> 5;
  ALAS float* ws = (ALAS float*)(lds + R_WS) + wid * 64; ALAS float* li_l = ws; ALAS float* al_l = ws + 32;
  float m_reg = -1e30f, l_reg = 0; f32x16 o[4] = {}; bf16x8 qr[12];
  { const bf16_t* Qw = Qb + (unsigned)((wid * 32 + r32) * ldq + hi * 8);
#pragma unroll
    for (int d0 = 0; d0 < 12; ++d0) qr[d0] = *reinterpret_cast<const bf16x8*>(Qw + d0 * 16); }
  unsigned koA, koB, voA, voB, kro;
  { const int q0 = wid * 64 + lane, q1 = q0 + 512;
    koA = (unsigned)((q0 >> 4) * ldkv + (((q0 & 15) ^ ((q0 >> 4) & 15)) * 8)); koB = (unsigned)((q1 >> 4) * ldkv + (((q1 & 15) ^ ((q1 >> 4) & 15)) * 8));
    { const int st = q0 >> 5, kk = ((st >> 2) << 3) | ((q0 >> 2) & 7), k = (kk & ~0xC) | ((kk & 4) << 1) | ((kk & 8) >> 1), c = (st & 3) * 32 + (q0 & 3) * 8; voA = (unsigned)(k * ldkv + c); }
    { const int st = q1 >> 5, kk = ((st >> 2) << 3) | ((q1 >> 2) & 7), k = (kk & ~0xC) | ((kk & 4) << 1) | ((kk & 8) >> 1), c = (st & 3) * 32 + (q1 & 3) * 8; voB = (unsigned)(k * ldkv + c); }
    { const int r = q0 >> 3, cl = (q0 & 7) ^ ((r >> 1) & 7); kro = (unsigned)(r * 64 + cl * 8); } }
  const int vbl = (int)(unsigned)(__UINTPTR_TYPE__)lds + R_V + v_rd_base(lane);
  const int kl0 = r32 * 256, kx = ((r32 & 15) << 4), krl0 = r32 * 128, krx = (((r32 >> 1) & 7) << 4);
#define DMA(t, s) do { const bf16_t* kb_ = Kh + (size_t)(t) * 64 * ldkv; const bf16_t* vb_ = Vh + (size_t)(t) * 64 * ldkv; const bf16_t* rb_ = Krh + (size_t)(t) * 4096; \
    __builtin_amdgcn_global_load_lds((const unsigned*)(kb_ + koA), (ALAS unsigned*)(lds + R_K + (s) * 16384 + wid * 1024), 16, 0, 0); \
    __builtin_amdgcn_global_load_lds((const unsigned*)(kb_ + koB), (ALAS unsigned*)(lds + R_K + (s) * 16384 + 8192 + wid * 1024), 16, 0, 0); \
    __builtin_amdgcn_global_load_lds((const unsigned*)(vb_ + voA), (ALAS unsigned*)(lds + R_V + (s) * 16384 + wid * 1024), 16, 0, 0); \
    __builtin_amdgcn_global_load_lds((const unsigned*)(vb_ + voB), (ALAS unsigned*)(lds + R_V + (s) * 16384 + 8192 + wid * 1024), 16, 0, 0); \
    __builtin_amdgcn_global_load_lds((const unsigned*)(rb_ + kro), (ALAS unsigned*)(lds + R_KR + (s) * 8192 + wid * 1024), 16, 0, 0); } while (0)
#define KLD(d0, row32) (*(const ALAS bf16x8*)(Ks + kl0 + (row32) * 8192 + ((((d0) * 16 + hi * 8) * 2) ^ kx)))
#define KRLD(d0, row32) (*(const ALAS bf16x8*)(Krs + krl0 + (row32) * 4096 + ((((d0) * 16 + hi * 8) * 2) ^ krx)))
  f32x16 p0, p1; float mn, al; bf16x8 pa0, pa1, pa2, pa3;
  DMA(0, 0); DMA(1, 1);
  int s = 0;
  for (int j = 0; j < NT; ++j) {
    if (j + 1 < NT) asm volatile("s_waitcnt vmcnt(5)" ::: "memory"); else asm volatile("s_waitcnt vmcnt(0)" ::: "memory");
    __builtin_amdgcn_s_barrier(); asm volatile("" ::: "memory");
    if (j + 2 < NT) { const int s2 = s == 0 ? 2 : s - 1; DMA(j + 2, s2); }
    SBAR();
    { const ALAS char* Ks = lds + R_K + s * 16384; const ALAS char* Krs = lds + R_KR + s * 8192;
      p0 = f32x16{}; p1 = f32x16{};
      bf16x8 b0 = KLD(0, 0), b1 = KLD(0, 1);
#pragma unroll
      for (int d0 = 0; d0 < 12; ++d0) {
        bf16x8 n0, n1;
        if (d0 + 1 < 8) { n0 = KLD(d0 + 1, 0); n1 = KLD(d0 + 1, 1); } else if (d0 + 1 < 12) { n0 = KRLD(d0 + 1 - 8, 0); n1 = KRLD(d0 + 1 - 8, 1); }
        p0 = __builtin_amdgcn_mfma_f32_32x32x16_bf16(b0, qr[d0], p0, 0, 0, 0);
        p1 = __builtin_amdgcn_mfma_f32_32x32x16_bf16(b1, qr[d0], p1, 0, 0, 0);
        if (d0 + 1 < 12) { b0 = n0; b1 = n1; }
      } }
    partialSM(p0, p1, m_reg, mn, al, C, thr_raw);
    if (__any(al < 1.f)) { if (hi == 0) al_l[r32] = al; asm volatile("s_waitcnt lgkmcnt(0)" ::: "memory");
#pragma unroll
      for (int d = 0; d < 4; ++d)
#pragma unroll
        for (int r = 0; r < 16; ++r) o[d][r] *= al_l[crow(r, hi)]; }
    finishSM(p0, p1, al, l_reg, pa0, pa1, pa2, pa3); SBAR();
    pv_d0(o, vbl + s * 16384, pa0, pa1, pa2, pa3);
    SBAR();
    s = s == 2 ? 0 : s + 1;
  }
  if (hi == 0) li_l[r32] = l_reg; asm volatile("s_waitcnt lgkmcnt(0)" ::: "memory");
  bf16_t* Ow = Ob + (unsigned)(wid * 32 * ldo + r32);
#pragma unroll
  for (int r = 0; r < 16; ++r) { const int orow = crow(r, hi); const float rl = __builtin_amdgcn_rcpf(li_l[orow]);
#pragma unroll
    for (int d0 = 0; d0 < 4; ++d0) Ow[(unsigned)(orow * ldo + d0 * 32)] = (bf16_t)(cvtpk(o[d0][r] * rl, 0.f) & 0xffffu); }
  __syncthreads();
#undef DMA
#undef KLD
#undef KRLD
}
}
#define LAS __attribute__((address_space(3)))
typedef unsigned short bf16;
typedef unsigned v4u __attribute__((ext_vector_type(4)));
typedef float f32x4 __attribute__((ext_vector_type(4)));
constexpr int NWAVES = 8;
#ifndef PHMASK
#define PHMASK 0xFFFF
#endif
#define PHON(k) constexpr ((PHMASK >> (k)) & 1)
#ifndef REP_MASK
#define REP_MASK 0
#endif
#define REPS(k) for (int rep_ = 0; rep_ < (((REP_MASK >> (k)) & 1) ? 2 : 1); ++rep_)
constexpr int LDS_BYTES = 131072 + 1024;
__device__ __forceinline__ unsigned pk2(float lo, float hi) { unsigned r; asm volatile("v_cvt_pk_bf16_f32 %0, %1, %2" : "=v"(r) : "v"(lo), "v"(hi)); return r; }
__device__ __forceinline__ float bflo(unsigned w) { return __uint_as_float(w << 16); }
__device__ __forceinline__ float bfhi(unsigned w) { return __uint_as_float(w & 0xffff0000u); }
__device__ __forceinline__ float wave_sum(float v) {
#pragma unroll
    for (int o = 1; o < 64; o <<= 1) v += __shfl_xor(v, o);
    return v;
}
__device__ __forceinline__ int map_win(int n) {
    if (n < 3072) { const int base = n < 1536 ? 0 : 1536, r = n - base, head = r >> 7, pc = r & 127; return base + head * 128 + (pc >> 1) + (pc & 1) * 64; }
    if (n < 5632) return n;
    if (n < 9728) return n + 64;
    const int pc = n - 9728; if (pc < 64) return 5632 + (pc >> 1) + (pc & 1) * 32;
    return -1;
}
__device__ __forceinline__ int map_wuq(int n) {
    if (n < 2048) return (n >> 7) * 192 + (n & 127);
    const int r = n - 2048, head = r >> 6, pc = r & 63; return head * 192 + 128 + (pc >> 1) + (pc & 1) * 32;
}
typedef float f32x2_ __attribute__((ext_vector_type(2)));
template <int MAP>
__device__ __forceinline__ void transpose_item(const float* __restrict__ W, int K, int N, int Np, const float* __restrict__ gain, bf16* __restrict__ WT, LAS float* scr, int item, int lane) {
    const int nblk = Np / 32, kb = item / nblk, nb = item % nblk, k0 = 64 * kb, n0 = 32 * nb;
    f32x4 v[8];
#pragma unroll
    for (int i = 0; i < 8; ++i) {
        const int idx = i * 64 + lane, kk = idx >> 3, np = n0 + (idx & 7) * 4;
        const float* row = W + (size_t)(k0 + kk) * N;
        int col = np, ilv = -1;
        int half = 64;
        if (MAP == 1) {
            if (np < 3072) { const int base = np < 1536 ? 0 : 1536, r = np - base; ilv = base + (r >> 7) * 128 + ((r & 127) >> 1); }
            else if (np < 5632) col = np;
            else if (np < 9728) col = np + 64;
            else if (np < 9792) { ilv = 5632 + ((np - 9728) >> 1); half = 32; }
            else col = -1;
        } else if (MAP == 2) {
            if (np < 2048) col = (np >> 7) * 192 + (np & 127);
            else { const int r = np - 2048; ilv = (r >> 6) * 192 + 128 + ((r & 63) >> 1); half = 32; }
        }
        if (ilv >= 0) { const f32x2_ a = *(const f32x2_*)(row + ilv), b = *(const f32x2_*)(row + ilv + half); v[i] = (f32x4){a.x, b.x, a.y, b.y}; }
        else if (col >= 0) v[i] = *(const f32x4*)(row + col);
        else v[i] = (f32x4){0.f, 0.f, 0.f, 0.f};
    }
#pragma unroll
    for (int i = 0; i < 8; ++i) {
        const int idx = i * 64 + lane, kk = idx >> 3, c4 = (idx & 7) * 4;
        const float g = gain ? gain[k0 + kk] : 1.f;
        scr[kk * 33 + c4 + 0] = v[i].x * g; scr[kk * 33 + c4 + 1] = v[i].y * g; scr[kk * 33 + c4 + 2] = v[i].z * g; scr[kk * 33 + c4 + 3] = v[i].w * g;
    }
    asm volatile("s_waitcnt lgkmcnt(0)" ::: "memory");
    const int c = lane & 7;
#pragma unroll
    for (int j = 0; j < 4; ++j) { const int n = (lane >> 3) + 8 * j; const LAS float* s = scr + (8 * c) * 33 + n;
        v4u o; o.x = pk2(s[0 * 33], s[1 * 33]); o.y = pk2(s[2 * 33], s[3 * 33]); o.z = pk2(s[4 * 33], s[5 * 33]); o.w = pk2(s[6 * 33], s[7 * 33]);
        *(v4u*)(WT + (size_t)(n0 + n) * K + k0 + 8 * c) = o; }
    asm volatile("s_waitcnt lgkmcnt(0)" ::: "memory");
}
__device__ __forceinline__ void rms_rows(const float* __restrict__ x, bf16* __restrict__ H, int gw, int NGW, int lane) {
    for (int m = gw; m < S_; m += NGW) {
        const f32x4* xr = (const f32x4*)(x + (size_t)m * DM) + lane; f32x4 v[8]; float s = 0.f;
#pragma unroll
        for (int j = 0; j < 8; ++j) { v[j] = xr[64 * j]; s += (v[j].x * v[j].x + v[j].y * v[j].y) + (v[j].z * v[j].z + v[j].w * v[j].w); }
        const float rstd = 1.f / sqrtf(wave_sum(s) * (1.f / DM) + EPS_);
        unsigned long long* o8 = (unsigned long long*)(H + (size_t)m * DM) + lane;
#pragma unroll
        for (int j = 0; j < 8; ++j) o8[64 * j] = (unsigned long long)pk2(v[j].x * rstd, v[j].y * rstd) | ((unsigned long long)pk2(v[j].z * rstd, v[j].w * rstd) << 32);
    }
}
__device__ __forceinline__ void rstd_rows_b(const bf16* __restrict__ X, float* __restrict__ R, int gw, int NGW, int lane) {
    for (int m = gw; m < S_; m += NGW) {
        const v4u* xr = (const v4u*)(X + (size_t)m * DM) + lane; float s = 0.f;
#pragma unroll
        for (int j = 0; j < 4; ++j) { const v4u w = xr[64 * j];
            const float a0 = bflo(w.x), a1 = bfhi(w.x), a2 = bflo(w.y), a3 = bfhi(w.y), a4 = bflo(w.z), a5 = bfhi(w.z), a6 = bflo(w.w), a7 = bfhi(w.w);
            s += (a0 * a0 + a1 * a1) + (a2 * a2 + a3 * a3) + (a4 * a4 + a5 * a5) + (a6 * a6 + a7 * a7); }
        const float rstd = 1.f / sqrtf(wave_sum(s) * (1.f / DM) + EPS_);
        if (lane == 0) R[m] = rstd;
    }
}
__device__ __forceinline__ void rms_rows_b(const bf16* __restrict__ X, bf16* __restrict__ H, int gw, int NGW, int lane) {
    for (int m = gw; m < S_; m += NGW) {
        const v4u* xr = (const v4u*)(X + (size_t)m * DM) + lane; v4u w[4]; float s = 0.f;
#pragma unroll
        for (int j = 0; j < 4; ++j) { w[j] = xr[64 * j];
            const float a0 = bflo(w[j].x), a1 = bfhi(w[j].x), a2 = bflo(w[j].y), a3 = bfhi(w[j].y), a4 = bflo(w[j].z), a5 = bfhi(w[j].z), a6 = bflo(w[j].w), a7 = bfhi(w[j].w);
            s += (a0 * a0 + a1 * a1) + (a2 * a2 + a3 * a3) + (a4 * a4 + a5 * a5) + (a6 * a6 + a7 * a7); }
        const float rstd = 1.f / sqrtf(wave_sum(s) * (1.f / DM) + EPS_);
        v4u* hr = (v4u*)(H + (size_t)m * DM) + lane;
#pragma unroll
        for (int j = 0; j < 4; ++j) { v4u o; o.x = pk2(bflo(w[j].x) * rstd, bfhi(w[j].x) * rstd); o.y = pk2(bflo(w[j].y) * rstd, bfhi(w[j].y) * rstd);
            o.z = pk2(bflo(w[j].z) * rstd, bfhi(w[j].z) * rstd); o.w = pk2(bflo(w[j].w) * rstd, bfhi(w[j].w) * rstd); hr[64 * j] = o; }
    }
}
__device__ __forceinline__ void rms512_inplace(bf16* __restrict__ A, int gw, int NGW, int lane) {
    for (int m = gw; m < S_; m += NGW) {
        v4u* p = (v4u*)(A + (size_t)m * 512) + lane; const v4u w = *p;
        float f[8] = {bflo(w.x), bfhi(w.x), bflo(w.y), bfhi(w.y), bflo(w.z), bfhi(w.z), bflo(w.w), bfhi(w.w)}; float s = 0.f;
#pragma unroll
        for (int e = 0; e < 8; ++e) s += f[e] * f[e];
        const float rstd = 1.f / sqrtf(wave_sum(s) * (1.f / 512) + EPS_);
        v4u o; o.x = pk2(f[0] * rstd, f[1] * rstd); o.y = pk2(f[2] * rstd, f[3] * rstd); o.z = pk2(f[4] * rstd, f[5] * rstd); o.w = pk2(f[6] * rstd, f[7] * rstd); *p = o;
    }
}
#define XB_TMO      128
#define XB_XCNT(j)  (256  + 64 * (j))
#define XB_XSUB(j)  (1280 + 64 * (j))
#define XB_XGEN(j)  (2304 + 64 * (j))
#define XB_TOP      3328
#define XB_TOPGEN   3392
#define XCD_BAR_WORDS 3456
#define XB_SPIN_CAP (1u << 23)

__device__ __forceinline__ unsigned xb_ld(unsigned* p)              { return __hip_atomic_load(p, __ATOMIC_RELAXED, __HIP_MEMORY_SCOPE_AGENT); }
__device__ __forceinline__ unsigned xb_add(unsigned* p, unsigned v) { return __hip_atomic_fetch_add(p, v, __ATOMIC_RELAXED, __HIP_MEMORY_SCOPE_AGENT); }
__device__ __forceinline__ unsigned xb_xcc_id() { return (unsigned)__builtin_amdgcn_s_getreg((3 << 11) | 20) & 0xFu; }
#define XB_SPIN(cond, bar) do { unsigned _sp = 0; while (cond) { __builtin_amdgcn_s_sleep(1); \
    if ((++_sp & 255u) == 0u) { if (xb_ld(&(bar)[XB_TMO])) break; if (_sp > XB_SPIN_CAP) { atomicAdd(&(bar)[XB_TMO], 1u); break; } } } } while (0)

struct XcdBarrier {
    unsigned* bar; unsigned x;
    volatile LAS unsigned* st;
};

__device__ __forceinline__ XcdBarrier xcd_barrier_post(unsigned* bar, volatile LAS unsigned* st) {
    XcdBarrier b; b.bar = bar; b.x = xb_xcc_id(); b.st = st;
    if (threadIdx.x == 0) (void)xb_add(&bar[XB_XCNT(b.x)], 1u);
    return b;
}
__device__ __forceinline__ void xcd_barrier_complete(unsigned* bar, unsigned x, unsigned& nloc, unsigned& nx) {
    const unsigned G = gridDim.x * gridDim.y * gridDim.z;
    unsigned sum, cnt, mine, sp = 0u;
    for (;;) {
        sum = 0u; cnt = 0u; mine = 0u;
#pragma unroll
        for (unsigned j = 0; j < 16; ++j) { const unsigned c = xb_ld(&bar[XB_XCNT(j)]); sum += c; cnt += (c > 0u) ? 1u : 0u; mine = (j == x) ? c : mine; }
        if (sum == G) break;
        __builtin_amdgcn_s_sleep(1);
        if ((++sp & 255u) == 0u) { if (xb_ld(&bar[XB_TMO])) break; if (sp > XB_SPIN_CAP) { atomicAdd(&bar[XB_TMO], 1u); break; } }
    }
    nloc = mine > 0u ? mine : 1u; nx = cnt > 0u ? cnt : 1u;
}

__device__ __forceinline__ void xcd_barrier(const XcdBarrier& b) {
    asm volatile("s_waitcnt vmcnt(0)" ::: "memory");
    __syncthreads();
    if (threadIdx.x == 0) {
        unsigned* bar = b.bar;
        __builtin_amdgcn_s_waitcnt(0);
        unsigned nloc = b.st[0], nx = b.st[1];
        if (nloc == 0u) { xcd_barrier_complete(bar, b.x, nloc, nx); b.st[0] = nloc; b.st[1] = nx; }
        const unsigned old = xb_add(&bar[XB_XSUB(b.x)], 1u);
        const unsigned gen = old / nloc;
        if (old + 1u == (gen + 1u) * nloc) {
            __builtin_amdgcn_fence(__ATOMIC_RELEASE, "agent");
            asm volatile("s_waitcnt vmcnt(0)" ::: "memory");
            const unsigned og = xb_add(&bar[XB_TOP], 1u);
            const unsigned tg = og / nx;
            if (og + 1u == (tg + 1u) * nx) xb_add(&bar[XB_TOPGEN], 1u);
            else XB_SPIN(xb_ld(&bar[XB_TOPGEN]) == tg, bar);
            __builtin_amdgcn_fence(__ATOMIC_ACQUIRE, "agent");
            xb_add(&bar[XB_XGEN(b.x)], 1u);
            asm volatile("s_waitcnt vmcnt(0)" ::: "memory");
        } else {
            XB_SPIN(xb_ld(&bar[XB_XGEN(b.x)]) == gen, bar);
            __builtin_amdgcn_fence(__ATOMIC_ACQUIRE, "agent");
            asm volatile("s_waitcnt vmcnt(0)" ::: "memory");
        }
    }
    __syncthreads();
}

struct Args { const float* in[18]; float* out; unsigned char* ws; int ph_lo, ph_hi; };
constexpr int PH_PER_LAYER = 11, PH_TOTAL = DEPTH_ * PH_PER_LAYER + 1;

#define GAS __attribute__((address_space(1)))
#define WB(off) ((bf16*)(GAS bf16*)(ws + (off)))
#define WF(off) ((float*)(GAS float*)(ws + (off)))
#define GIN(k) ((const float*)(const GAS float*)ap->in[k])
#define GOUT ((float*)(GAS float*)ap->out)
#define SEAM(k) do { RELOAD(); if ((k) + 1 < ap->ph_hi) { if ((k) == 0) { __syncthreads(); grid.sync(); } else xcd_barrier(xbar); } RELOAD(); } while (0)
#define GEMM_PHASE(MODE, Aoff, Boff, N_, K_, F0, FO) do { pg8::Gemm g{WB(Aoff), WB(Boff), S_, (N_), (K_)}; int G_ = gridDim.x, bx_ = blockIdx.x; asm volatile("" : "+s"(G_), "+s"(bx_)); pg8::StaticOrder SO; SO.init(S_, (N_), G_, bx_); \
    pg8::Epi<pg8::MODE> E{{ws, (F0), (FO)}}; pg8::gemm_phase<pg8::Epi<pg8::MODE>, pg8::StaticOrder, true, true>((LAS unsigned char*)lds, g, SO, E); } while (0)
#define GEMM_PHASE_A(MODE, Aptr, Boff, N_, K_, F0, FO) do { pg8::Gemm g{(Aptr), WB(Boff), S_, (N_), (K_)}; int G_ = gridDim.x, bx_ = blockIdx.x; asm volatile("" : "+s"(G_), "+s"(bx_)); pg8::StaticOrder SO; SO.init(S_, (N_), G_, bx_); \
    pg8::Epi<pg8::MODE> E{{ws, (F0), (FO)}}; pg8::gemm_phase<pg8::Epi<pg8::MODE>, pg8::StaticOrder, true, true>((LAS unsigned char*)lds, g, SO, E); } while (0)

__global__ void __launch_bounds__(NWAVES * 64, 2) mega_fwd(Args args) {
    extern __shared__ __attribute__((aligned(16))) unsigned char lds[];
    cg::grid_group grid = cg::this_grid();
    { volatile LAS unsigned* st0 = (volatile LAS unsigned*)((LAS unsigned char*)lds + 131072); if (threadIdx.x < 64) st0[threadIdx.x] = 0u; }
    __syncthreads();
    XcdBarrier xbar = xcd_barrier_post((unsigned*)args.ws, (volatile LAS unsigned*)((LAS unsigned char*)lds + 131072));
    typedef const __attribute__((address_space(4))) Args* ArgsP; ArgsP ap = (ArgsP)__builtin_amdgcn_kernarg_segment_ptr();
    unsigned char* ws;
#define RELOAD() do { asm volatile("" : "+s"(ap)); ws = ap->ws; asm volatile("" : "+s"(ws)); } while (0)
#define TIDS int tid_ = threadIdx.x, G_ = gridDim.x, bx_ = blockIdx.x; asm volatile("" : "+v"(tid_), "+s"(G_), "+s"(bx_)); const int tid = tid_, lane = tid & 63, wave = __builtin_amdgcn_readfirstlane(tid >> 6); const int G = G_, bx = bx_; \
    const int gw = bx * NWAVES + wave, NGW = G * NWAVES; const long gt = (long)bx * 512 + tid, NGT = (long)G * 512; (void)lane; (void)gw; (void)NGW; (void)gt; (void)NGT;
#pragma nounroll
    for (int l = 0; l < DEPTH_; ++l) {
#define pb (l * PH_PER_LAYER)
#define IN(k) (ap->ph_lo <= pb + (k) && pb + (k) < ap->ph_hi)
        RELOAD();
        if (IN(0)) { if PHON(0) REPS(0) {
            TIDS
            const float *norm_mix = GIN(2) + (size_t)l * DM, *w_in = GIN(3) + (size_t)l * DM * NIN, *norm_q = GIN(5) + (size_t)l * QLORA, *w_uq = GIN(6) + (size_t)l * QLORA * 3072,
                        *norm_kv = GIN(7) + (size_t)l * KVLORA, *w_ukv = GIN(8) + (size_t)l * KVLORA * 4096, *w_oa = GIN(9) + (size_t)l * 512 * DM, *w_ob = GIN(10) + (size_t)l * DM * DM,
                        *w_out = GIN(11) + (size_t)l * DM * DM, *norm_ffn = GIN(12) + (size_t)l * DM, *w_up = GIN(13) + (size_t)l * DM * 2 * DFF, *w_down = GIN(16) + (size_t)l * DFF * DM;
            LAS float* scr = (LAS float*)((LAS unsigned char*)lds + wave * 16384);
            constexpr int I_IN = (DM / 64) * (NINP / 32), I_UQ = (512 / 64) * (3072 / 32), I_UKV = (512 / 64) * (4096 / 32), I_OA = (512 / 64) * (DM / 32), I_OB = (DM / 64) * (DM / 32), I_OUT = I_OB,
                          I_UP = (DM / 64) * (2 * DFF / 32), I_DN = (DFF / 64) * (DM / 32);
            constexpr int NITEMS = I_IN + I_UQ + I_UKV + I_OA + I_OB + I_OUT + I_UP + I_DN;
            for (int it = gw; it < NITEMS; it += NGW) {
                int r = it;
                if (r < I_IN) { transpose_item<1>(w_in, DM, NIN, NINP, norm_mix, WB(WS_WIN), scr, r, lane); continue; } r -= I_IN;
                if (r < I_UQ) { transpose_item<2>(w_uq, 512, 3072, 3072, norm_q, WB(WS_WUQ), scr, r, lane); continue; } r -= I_UQ;
                if (r < I_UKV) { transpose_item<0>(w_ukv, 512, 4096, 4096, norm_kv, WB(WS_WUKV), scr, r, lane); continue; } r -= I_UKV;
                if (r < I_OA) { transpose_item<0>(w_oa, 512, DM, DM, nullptr, WB(WS_WOA), scr, r, lane); continue; } r -= I_OA;
                if (r < I_OB) { transpose_item<0>(w_ob, DM, DM, DM, nullptr, WB(WS_WOB), scr, r, lane); continue; } r -= I_OB;
                if (r < I_OUT) { transpose_item<0>(w_out, DM, DM, DM, nullptr, WB(WS_WOUT), scr, r, lane); continue; } r -= I_OUT;
                if (r < I_UP) { transpose_item<0>(w_up, DM, 2 * DFF, 2 * DFF, norm_ffn, WB(WS_WUP), scr, r, lane); continue; } r -= I_UP;
                transpose_item<0>(w_down, DFF, DM, DM, nullptr, WB(WS_WDN), scr, r, lane);
            }
            if (l == 0) {
                const int* positions = (const int*)GIN(1);
                for (long i = gt; i < (long)S_ * 96; i += NGT) {
                    const int s = (int)(i / 96), j = (int)(i % 96); const double pos = (double)positions[s];
                    const bool isA = j < 64; const int e = isA ? j : j - 64;
                    double base = isA ? 0.8659643233600653 : 0.7498942093324559, inv = 1.0;
#pragma unroll
                    for (int bit = 0; bit < 6; ++bit) { if ((e >> bit) & 1) inv *= base; base *= base; }
                    double t = pos * inv * 0.15915494309189535; t -= rint(t);
                    const float tf = (float)t;
                    float* dst = isA ? WF(WS_ROPEA) + ((size_t)s * 64 + e) * 2 : WF(WS_ROPEB) + ((size_t)s * 32 + e) * 2;
                    dst[0] = __builtin_amdgcn_cosf(tf); dst[1] = __builtin_amdgcn_sinf(tf);
                }
            }
            if (l == 0) { rms_rows(GIN(0), WB(WS_H), gw, NGW, lane); for (long i = gt; i < S_; i += NGT) WF(WS_RSTD)[i] = 1.f; } else rstd_rows_b((const bf16*)(GAS bf16*)((GAS unsigned char*)ap->out + 67108864), WF(WS_RSTD), gw, NGW, lane);
        } SEAM(pb + 0); }
        if (IN(1)) { if PHON(1) REPS(1) {
            if (l == 0) GEMM_PHASE(EP_IN, WS_H, WS_WIN, NINP, DM, GIN(4) + (size_t)l * 4096, nullptr); else GEMM_PHASE_A(EP_IN, (const bf16*)(GAS bf16*)((GAS unsigned char*)ap->out + 67108864), WS_WIN, NINP, DM, GIN(4) + (size_t)l * 4096, nullptr);
        } SEAM(pb + 1); }
        if (IN(2)) { if PHON(2) {
            TIDS
            rms512_inplace(WB(WS_QL), gw, NGW, lane); rms512_inplace(WB(WS_KVL), gw, NGW, lane);
            const float scale = 0.08838834764831845f, C = scale * 1.4426950408889634f;
            REPS(2) for (int u = bx; u < 768; u += G) {
                const int g = u >> 8, rem = u & 255, head = rem >> 6, idx = rem & 63;
                const int dsh = 2 * g, d = 1 << dsh, L = S_ >> dsh, nqb = L >> 8, r = idx / nqb, qb = idx % nqb, t0 = qb * 256;
                int ks = t0 - 64; if (ks < 0) ks = 0; if (ks > L - 384) ks = L - 384;
                const int pitch = d * WA; const int hc = (g * 4 + head) * 128;
                const bf16* Qp = WB(WS_QA) + (size_t)(r + d * t0) * WA + hc; const bf16* Kp = WB(WS_KA) + (size_t)(r + d * ks) * WA + hc; const bf16* Vp = WB(WS_VA) + (size_t)(r + d * ks) * WA + hc;
                bf16* Op = WB(WS_OG) + (size_t)(r + d * t0) * WA + hc; float* Lp = WF(WS_LSE) + (size_t)(r + d * t0) * 12 + g * 4 + head;
                att::attn_unit<0, true>(Qp, pitch, Kp, pitch, Kp, Vp, pitch, Op, pitch, Lp, d * 12, 6, t0 - ks, C, 8.f / scale, scale, (char*)lds);
            }
        } SEAM(pb + 2); }
        if (IN(3)) { if PHON(3) REPS(3) {
            GEMM_PHASE(EP_CQ, WS_QL, WS_WUQ, 3072, 512, nullptr, nullptr);
            GEMM_PHASE(EP_CKV, WS_KVL, WS_WUKV, 4096, 512, nullptr, nullptr);
            TIDS
            const float* LSE = WF(WS_LSE); const bf16* OG = WB(WS_OG); bf16* OA = WB(WS_OA);
            for (long i = gt; i < (long)S_ * 64; i += NGT) {
                const int s = (int)(i >> 6), hh = (int)(i >> 4) & 3, ch = (int)i & 15;
                const float l0 = LSE[(size_t)s * 12 + hh], l1 = LSE[(size_t)s * 12 + 4 + hh], l2 = LSE[(size_t)s * 12 + 8 + hh];
                const float mx = fmaxf(l0, fmaxf(l1, l2)); float w0 = __expf(l0 - mx), w1 = __expf(l1 - mx), w2 = __expf(l2 - mx); const float inv = 1.f / (w0 + w1 + w2); w0 *= inv; w1 *= inv; w2 *= inv;
                const v4u a = *(const v4u*)(OG + (size_t)s * WA + hh * 128 + ch * 8), b = *(const v4u*)(OG + (size_t)s * WA + (4 + hh) * 128 + ch * 8), c = *(const v4u*)(OG + (size_t)s * WA + (8 + hh) * 128 + ch * 8);
                v4u o;
                o.x = pk2(w0 * bflo(a.x) + w1 * bflo(b.x) + w2 * bflo(c.x), w0 * bfhi(a.x) + w1 * bfhi(b.x) + w2 * bfhi(c.x));
                o.y = pk2(w0 * bflo(a.y) + w1 * bflo(b.y) + w2 * bflo(c.y), w0 * bfhi(a.y) + w1 * bfhi(b.y) + w2 * bfhi(c.y));
                o.z = pk2(w0 * bflo(a.z) + w1 * bflo(b.z) + w2 * bflo(c.z), w0 * bfhi(a.z) + w1 * bfhi(b.z) + w2 * bfhi(c.z));
                o.w = pk2(w0 * bflo(a.w) + w1 * bflo(b.w) + w2 * bflo(c.w), w0 * bfhi(a.w) + w1 * bfhi(b.w) + w2 * bfhi(c.w));
                *(v4u*)(OA + (size_t)s * 512 + hh * 128 + ch * 8) = o;
            }
        } SEAM(pb + 3); }
        if (IN(4)) { if PHON(4) REPS(4) {
            int G = gridDim.x, bx = blockIdx.x; asm volatile("" : "+s"(G), "+s"(bx));
            const float scale = 0.07216878364870323f, C = scale * 1.4426950408889634f;
#if defined(ATT_PROBE)
            for (int u = bx; u < 1024; u += G) {
                const int xc = u & 7, rest = u >> 3, pair = (rest >> 5) * 8 + xc, head = pair >> 1, qb = (pair & 1) * 32 + (rest & 31);
                att::attn_unit2<4, ATT_PROBE>(WB(WS_QB) + (size_t)qb * 256 * 3072 + head * 192, 3072, WB(WS_KN) + head * 128, 2048, WB(WS_KPE), WB(WS_VB) + head * 128, 2048,
                                   WB(WS_T) + (size_t)qb * 256 * 2048 + head * 128, 2048, S_ / 64, C, 8.f / scale, (char*)lds);
            }
            __syncthreads(); grid.sync();
#endif
            for (int u = bx; u < 1024; u += G) {
                const int xc = u & 7, rest = u >> 3, pair = (rest >> 5) * 8 + xc, head = pair >> 1, qb = (pair & 1) * 32 + (rest & 31);
                att::attn_unit7((const unsigned char*)(GAS unsigned char*)(ws + WS_QB) + (size_t)qb * 256 * 3072 + head * 192, 3072, (const unsigned char*)(GAS unsigned char*)(ws + WS_KN) + head * 128, 2048,
                                (const unsigned char*)(GAS unsigned char*)(ws + WS_KPE), (const unsigned char*)(GAS unsigned char*)(ws + WS_VB) + (size_t)head * (S_ / 64) * 8192,
                                WB(WS_H) + (size_t)qb * 256 * 2048 + head * 128, 2048, S_ / 64, C, 1.4426950408889634f, (char*)lds);
            }
#ifndef NO_YA
            GEMM_PHASE(EP_YA, WS_OA, WS_WOA, DM, 512, nullptr, nullptr);
#endif
        } SEAM(pb + 4); }
        if (IN(5)) { if PHON(5) REPS(5) {
            GEMM_PHASE(EP_YB, WS_H, WS_WOB, DM, DM, nullptr, nullptr);
        } SEAM(pb + 5); }
        if (IN(6)) { if PHON(6) {
            GEMM_PHASE(EP_RES, WS_MERGED, WS_WOUT, DM, DM, (l == 0 ? GIN(0) : (const float*)nullptr), GOUT);
        } SEAM(pb + 6); }
        if (IN(7)) { if PHON(7) { TIDS rstd_rows_b((const bf16*)(GAS bf16*)((GAS unsigned char*)ap->out + 67108864), WF(WS_RSTD), gw, NGW, lane); } SEAM(pb + 7); }
        if (IN(8)) { if PHON(8) REPS(8) {
            GEMM_PHASE_A(EP_U, (const bf16*)(GAS bf16*)((GAS unsigned char*)ap->out + 67108864), WS_WUP, 2 * DFF, DM, nullptr, nullptr);
        } SEAM(pb + 8); }
        if (IN(9)) { if PHON(9) REPS(9) {
            TIDS
            const float *cw = GIN(14) + (size_t)l * 3 * 2 * DFF, *cb = GIN(15) + (size_t)l * 2 * DFF; const bf16* U = WB(WS_U); bf16* GG = WB(WS_G);
            constexpr int NCG = DFF / 8;
            const int nsl = (int)(NGT / NCG), rps = (S_ + nsl - 1) / nsl, cgp = (int)(gt % NCG), sl = (int)(gt / NCG);
            if (sl < nsl && sl * rps < S_) {
                const int c = cgp * 8, sb = sl * rps, se = (sb + rps < S_) ? sb + rps : S_;
                float wa[3][8], wb[3][8], ba[8], bb[8];
#pragma unroll
                for (int t = 0; t < 3; ++t)
#pragma unroll
                    for (int e = 0; e < 8; ++e) { wa[t][e] = cw[(size_t)t * 2 * DFF + c + e]; wb[t][e] = cw[(size_t)t * 2 * DFF + DFF + c + e]; }
#pragma unroll
                for (int e = 0; e < 8; ++e) { ba[e] = cb[c + e]; bb[e] = cb[DFF + c + e]; }
                const v4u z = {0u, 0u, 0u, 0u};
#define LDU(s, off) (((s) >= 0 && (s) < S_) ? __builtin_nontemporal_load((const v4u*)(U + (size_t)(s) * 2 * DFF + (off) + c)) : z)
                v4u ra[6], rb[6], na[4], nb[4];
#pragma unroll
                for (int k = 0; k < 6; ++k) { ra[k] = LDU(sb - 1 + k, 0); rb[k] = LDU(sb - 1 + k, DFF); }
                for (int s = sb; s < se; s += 4) {
#pragma unroll
                    for (int k = 0; k < 4; ++k) { na[k] = LDU(s + 5 + k, 0); nb[k] = LDU(s + 5 + k, DFF); }
#define CV(e, P, Cc, Nn, W, Bv) (Bv[e] + W[0][e] * ((e & 1) ? bfhi(P[e >> 1]) : bflo(P[e >> 1])) + W[1][e] * ((e & 1) ? bfhi(Cc[e >> 1]) : bflo(Cc[e >> 1])) + W[2][e] * ((e & 1) ? bfhi(Nn[e >> 1]) : bflo(Nn[e >> 1])))
#pragma unroll
                    for (int k = 0; k < 4; ++k) {
                        if (s + k < se) {
                            float ga[8];
#pragma unroll
                            for (int e = 0; e < 8; ++e) { const float ua = CV(e, ra[k], ra[k + 1], ra[k + 2], wa, ba), ub = CV(e, rb[k], rb[k + 1], rb[k + 2], wb, bb); ga[e] = ua * __builtin_amdgcn_rcpf(1.f + __expf(-ua)) * ub; }
                            v4u o; o.x = pk2(ga[0], ga[1]); o.y = pk2(ga[2], ga[3]); o.z = pk2(ga[4], ga[5]); o.w = pk2(ga[6], ga[7]);
                            *(v4u*)(GG + (size_t)(s + k) * DFF + c) = o;
                        }
                    }
#undef CV
                    ra[0] = ra[4]; ra[1] = ra[5]; rb[0] = rb[4]; rb[1] = rb[5];
#pragma unroll
                    for (int k = 0; k < 4; ++k) { ra[2 + k] = na[k]; rb[2 + k] = nb[k]; }
                }
#undef LDU
            }
        } SEAM(pb + 9); }
        if (IN(10)) { if PHON(10) {
            GEMM_PHASE(EP_RES, WS_G, WS_WDN, DM, DFF, (const float*)nullptr, GOUT);
        } SEAM(pb + 10); }
#undef IN
#undef pb
    }
    RELOAD();
    if (ap->ph_lo <= PH_TOTAL - 1 && PH_TOTAL - 1 < ap->ph_hi) {
        TIDS
        const bf16* XBp = (const bf16*)(GAS bf16*)((GAS unsigned char*)ap->out + 67108864); float* outp = GOUT; const float* gfin = GIN(17);
        v4u rw[8][4];
#pragma unroll
        for (int i = 0; i < 8; ++i) { const int row = gw + i * NGW;
#pragma unroll
            for (int j = 0; j < 4; ++j) rw[i][j] = row < S_ ? ((const v4u*)(XBp + (size_t)row * DM))[64 * j + lane] : (v4u){0u, 0u, 0u, 0u}; }
        asm volatile("s_waitcnt vmcnt(0)" ::: "memory");
        { XcdBarrier xb_; xb_.bar = (unsigned*)ws; xb_.x = xb_xcc_id(); xb_.st = (volatile LAS unsigned*)((LAS unsigned char*)lds + 131072); xcd_barrier(xb_); }
#pragma unroll
        for (int i = 0; i < 8; ++i) { const int row = gw + i * NGW; float s = 0.f;
#pragma unroll
            for (int j = 0; j < 4; ++j) { const v4u w = rw[i][j];
                const float a0 = bflo(w.x), a1 = bfhi(w.x), a2 = bflo(w.y), a3 = bfhi(w.y), a4 = bflo(w.z), a5 = bfhi(w.z), a6 = bflo(w.w), a7 = bfhi(w.w);
                s += (a0 * a0 + a1 * a1) + (a2 * a2 + a3 * a3) + (a4 * a4 + a5 * a5) + (a6 * a6 + a7 * a7); }
            const float rstd = 1.f / sqrtf(wave_sum(s) * (1.f / DM) + EPS_);
            if (row < S_) {
#pragma unroll
                for (int j = 0; j < 4; ++j) { const v4u w = rw[i][j]; const int c = (64 * j + lane) * 8; const f32x4 g0 = *(const f32x4*)(gfin + c), g1 = *(const f32x4*)(gfin + c + 4);
                    f32x4 o0 = {bflo(w.x), bfhi(w.x), bflo(w.y), bfhi(w.y)}, o1 = {bflo(w.z), bfhi(w.z), bflo(w.w), bfhi(w.w)};
                    *(f32x4*)(outp + (size_t)row * DM + c) = o0 * rstd * g0; *(f32x4*)(outp + (size_t)row * DM + c + 4) = o1 * rstd * g1; } }
        }
    }
}

extern "C" void kernel_launch(void* const* d_in, const int* in_sizes, int n_in, void* d_out, int out_size, void* d_ws, size_t ws_size, hipStream_t stream) {
    static int grid = 0;
    if (grid == 0) {
        if (n_in != 18 || out_size != S_ * DM || ws_size < WS_END) { fprintf(stderr, "kernel_launch: unexpected shapes (n_in %d out %d ws %zu)\n", n_in, out_size, ws_size); grid = -1; return; }
        int dev = 0, cus = 0, per_cu = 0;
        hipGetDevice(&dev); hipDeviceGetAttribute(&cus, hipDeviceAttributeMultiprocessorCount, dev);
        if (hipFuncSetAttribute((const void*)mega_fwd, hipFuncAttributeMaxDynamicSharedMemorySize, LDS_BYTES) != hipSuccess) { fprintf(stderr, "kernel_launch: hipFuncSetAttribute failed\n"); grid = -1; return; }
        if (hipOccupancyMaxActiveBlocksPerMultiprocessor(&per_cu, (const void*)mega_fwd, NWAVES * 64, LDS_BYTES) != hipSuccess || per_cu < 1) { fprintf(stderr, "kernel_launch: occupancy query gave %d\n", per_cu); per_cu = 1; }
        (void)hipGetLastError();
        grid = cus * 1;
    }
    if (grid < 0) return;
    if (hipMemsetAsync(d_ws, 0, 16384, stream) != hipSuccess) { fprintf(stderr, "kernel_launch: hipMemsetAsync failed\n"); return; }
    Args a{};
    for (int i = 0; i < 18; ++i) a.in[i] = (const float*)d_in[i];
    a.out = (float*)d_out; a.ws = (unsigned char*)d_ws;
#ifndef MK_SPLIT
    a.ph_lo = 0; a.ph_hi = PH_TOTAL;
    void* kargs[] = {&a};
    hipError_t e = hipLaunchCooperativeKernel((const void*)mega_fwd, dim3(grid), dim3(NWAVES * 64), kargs, LDS_BYTES, stream);
    if (e != hipSuccess) fprintf(stderr, "cooperative launch failed: %s (grid %d)\n", hipGetErrorString(e), grid);
#else
    for (int ph = 0; ph < PH_TOTAL; ++ph) { a.ph_lo = ph; a.ph_hi = ph + 1; hipLaunchKernelGGL(mega_fwd, dim3(grid), dim3(NWAVES * 64), LDS_BYTES, stream, a); }
#endif
}
```

```cpp
#include <hip/hip_runtime.h>
#include <hip/hip_cooperative_groups.h>
#include <cstdio>
#include <cstdint>
#include <cmath>
namespace cg = cooperative_groups;

constexpr int S_ = 16384, DM = 2048, DEPTH_ = 2;
constexpr int WA = 1536, QLORA = 512, KVLORA = 512, QKROPE = 64, NIN = 9792, NINP = 9984;
constexpr int DFF = 5632;
constexpr float EPS_ = 1e-6f;
constexpr size_t MiB = 1u << 20;
constexpr size_t WS_ROPEA = 1 * MiB, WS_ROPEB = 9 * MiB, WS_RSTD = 13 * MiB;
constexpr size_t WS_WUP = 16 * MiB, WS_WDN = 60 * MiB, WS_WIN = 82 * MiB, WS_WUQ = 121 * MiB, WS_WUKV = 124 * MiB, WS_WOA = 128 * MiB, WS_WOB = 130 * MiB, WS_WOUT = 138 * MiB;
constexpr size_t WS_H = 146 * MiB;
constexpr size_t WS_QA = 210 * MiB, WS_KA = 258 * MiB, WS_VA = 306 * MiB;
constexpr size_t WS_KN = 210 * MiB, WS_VB = 274 * MiB, WS_OA = 338 * MiB;
constexpr size_t WS_OG = 354 * MiB, WS_QL = 402 * MiB;
constexpr size_t WS_T = 354 * MiB;
constexpr size_t WS_KVL = 418 * MiB, WS_KPE = 434 * MiB, WS_LSE = 436 * MiB, WS_GATES = 437 * MiB, WS_QB = 565 * MiB;
constexpr size_t WS_MERGED = 565 * MiB;
constexpr size_t WS_G = 82 * MiB, WS_U = 258 * MiB;
constexpr size_t WS_END = 661 * MiB;
namespace pg8 {
#define PG8_LAS __attribute__((address_space(3)))
typedef unsigned short bf16_t;
typedef short bf16x8 __attribute__((ext_vector_type(8)));
typedef float f32x4 __attribute__((ext_vector_type(4)));
typedef unsigned u32x4 __attribute__((ext_vector_type(4)));
constexpr int BM = 256, BK = 64, HALF = 128, HTB = HALF * BK * 2  , STAGE_BYTES = 8 * HTB, NXCD = 8, WGM = 4;

__host__ __device__ __forceinline__ int lds_byte(int r, int c) { const int st = (r >> 4) * 2 + (c >> 5), rr = r & 15, cc = c & 31, ob = rr * 64 + cc * 2; return st * 1024 + (ob ^ (((ob >> 9) & 1) << 5)); }
__host__ __device__ __forceinline__ void stage_rc(int b, int& R, int& C) { const int st = b / 1024, sb = b % 1024, swz = sb ^ (((sb >> 9) & 1) << 5); R = (st >> 1) * 16 + swz / 64; C = (st & 1) * 32 + (swz % 64) / 2; }
__host__ __device__ __forceinline__ int perm32(int rho) { const int n = rho >> 4, i = rho & 15; return 8 * (i >> 2) + 4 * n + (i & 3); }

struct Unit { int pm, pn; };
struct Gemm { const bf16_t* A; const bf16_t* Bt; int M, N, K; };

struct StaticOrder {
    int nM, nN, nwg, G, c;
    __host__ __device__ void init(int M, int N, int G_, int c_) { nM = M / BM; nN = N / BM; nwg = nM * nN; G = G_; c = c_; }
    __host__ __device__ bool next(int i, Unit& u) const {
        const long L = (long)i * G + c; if (L >= nwg) return false;
        int wgid = (int)L; { const int q = nwg / NXCD, r = nwg % NXCD, xcd = wgid % NXCD, off = wgid / NXCD; wgid = (xcd < r ? xcd * (q + 1) : r * (q + 1) + (xcd - r) * q) + off; }
        const int nig = WGM * nN, gid = wgid / nig, fm = gid * WGM, gsz = (nM - fm) < WGM ? (nM - fm) : WGM;
        u.pm = fm + ((wgid % nig) % gsz); u.pn = (wgid % nig) / gsz; return true;
    }
    __device__ __forceinline__ void a_ready(const Unit&) const {}
    __device__ __forceinline__ void done(const Unit&) const {}
};
__device__ __forceinline__ unsigned cvt_pk_bf16(float lo, float hi) { unsigned r; asm volatile("v_cvt_pk_bf16_f32 %0, %1, %2" : "=v"(r) : "v"(lo), "v"(hi)); return r; }
typedef float f32x2 __attribute__((ext_vector_type(2)));
typedef float f32x2 __attribute__((ext_vector_type(2)));
enum { EP_IN = 0, EP_CQ, EP_CKV, EP_YA, EP_YB, EP_RES, EP_U };
struct EpiP { unsigned char* ws; const float* f0; float* fo; };
#define EGAS __attribute__((address_space(1)))
#define WSB(off) ((EGAS bf16_t*)(p.ws + (off)))
#define WSF(off) ((const EGAS float*)(p.ws + (off)))
__device__ __forceinline__ void st8(EGAS bf16_t* dst, f32x4 v0, f32x4 v1) {
    u32x4 w; w.x = cvt_pk_bf16(v0[0], v0[1]); w.y = cvt_pk_bf16(v0[2], v0[3]); w.z = cvt_pk_bf16(v1[0], v1[1]); w.w = cvt_pk_bf16(v1[2], v1[3]); *(EGAS u32x4*)dst = w; }
__device__ __forceinline__ void st8nt(EGAS bf16_t* dst, f32x4 v0, f32x4 v1) {
    u32x4 w; w.x = cvt_pk_bf16(v0[0], v0[1]); w.y = cvt_pk_bf16(v0[2], v0[3]); w.z = cvt_pk_bf16(v1[0], v1[1]); w.w = cvt_pk_bf16(v1[2], v1[3]); __builtin_nontemporal_store(w, (EGAS u32x4*)dst); }
typedef unsigned u32x2e __attribute__((ext_vector_type(2)));
__device__ __forceinline__ void st8f8(EGAS unsigned char* dst, f32x4 v0, f32x4 v1) {
    int w0 = __builtin_amdgcn_cvt_pk_fp8_f32(v0[0], v0[1], 0, false); w0 = __builtin_amdgcn_cvt_pk_fp8_f32(v0[2], v0[3], w0, true);
    int w1 = __builtin_amdgcn_cvt_pk_fp8_f32(v1[0], v1[1], 0, false); w1 = __builtin_amdgcn_cvt_pk_fp8_f32(v1[2], v1[3], w1, true);
    *(EGAS u32x2e*)dst = (u32x2e){(unsigned)w0, (unsigned)w1}; }
#define WS8(off) ((EGAS unsigned char*)(p.ws + (off)))
__device__ __forceinline__ void ld8f8(const EGAS unsigned char* src, f32x4& v0, f32x4& v1) {
    typedef float f32x2g __attribute__((ext_vector_type(2)));
    const u32x2e w = *(const EGAS u32x2e*)src;
    const f32x2g a = __builtin_amdgcn_cvt_pk_f32_fp8((int)w.x, false), b = __builtin_amdgcn_cvt_pk_f32_fp8((int)w.x, true), c = __builtin_amdgcn_cvt_pk_f32_fp8((int)w.y, false), d = __builtin_amdgcn_cvt_pk_f32_fp8((int)w.y, true);
    v0 = (f32x4){a.x, a.y, b.x, b.y}; v1 = (f32x4){c.x, c.y, d.x, d.y}; }
__device__ __forceinline__ void ld8(const EGAS bf16_t* src, f32x4& v0, f32x4& v1) {
    const u32x4 w = *(const EGAS u32x4*)src;
    v0[0] = __uint_as_float(w.x << 16); v0[1] = __uint_as_float(w.x & 0xffff0000u); v0[2] = __uint_as_float(w.y << 16); v0[3] = __uint_as_float(w.y & 0xffff0000u);
    v1[0] = __uint_as_float(w.z << 16); v1[1] = __uint_as_float(w.z & 0xffff0000u); v1[2] = __uint_as_float(w.w << 16); v1[3] = __uint_as_float(w.w & 0xffff0000u); }
__device__ __forceinline__ void rope8(f32x4& v0, f32x4& v1, const EGAS float* tab) {
    const f32x4 c0 = *(const EGAS f32x4*)tab, c1 = *(const EGAS f32x4*)(tab + 4);
    f32x4 a, b;
    a[0] = v0[0] * c0[0] - v0[1] * c0[1]; a[1] = v0[1] * c0[0] + v0[0] * c0[1]; a[2] = v0[2] * c0[2] - v0[3] * c0[3]; a[3] = v0[3] * c0[2] + v0[2] * c0[3];
    b[0] = v1[0] * c1[0] - v1[1] * c1[1]; b[1] = v1[1] * c1[0] + v1[0] * c1[1]; b[2] = v1[2] * c1[2] - v1[3] * c1[3]; b[3] = v1[3] * c1[2] + v1[2] * c1[3];
    v0 = a; v1 = b; }
__device__ __forceinline__ float sigm(float x) { return __builtin_amdgcn_rcpf(1.f + __expf(-x)); }
template <int MODE> struct Epi {
    static constexpr bool PERM = true, AFTER_DRAIN = false;
    EpiP p;
    __device__ __forceinline__ void operator()(const f32x4 (&acc)[2][2][4][2], const Unit& u, int wr, int wc, int fr, int fq) const {
        const int row0 = u.pm * BM + wr * 64 + fr, pn = u.pn, cw = wc * 32 + 8 * fq;
        float rs[2][4];
#pragma unroll
        for (int ai = 0; ai < 2; ++ai)
#pragma unroll
            for (int m = 0; m < 4; ++m) rs[ai][m] = 1.f;
        if constexpr (MODE == EP_IN || MODE == EP_U) {
            const EGAS float* rsp = WSF(WS_RSTD) + row0;
#pragma unroll
            for (int ai = 0; ai < 2; ++ai)
#pragma unroll
                for (int m = 0; m < 4; ++m) rs[ai][m] = rsp[ai * HALF + m * 16];
        }
#pragma unroll
        for (int ai = 0; ai < 2; ++ai)
#pragma unroll
            for (int m = 0; m < 4; ++m) {
                const unsigned row = (unsigned)(row0 + ai * HALF + m * 16);
#pragma unroll
                for (int bj = 0; bj < 2; ++bj) {
                    f32x4 v0 = acc[ai][bj][m][0], v1 = acc[ai][bj][m][1];
                    if constexpr (MODE == EP_IN || MODE == EP_U) { v0 = v0 * rs[ai][m]; v1 = v1 * rs[ai][m]; }
                    const int ct = bj * HALF + cw;
                    if constexpr (MODE == EP_IN) {
                        if (pn < 12) {
                            rope8(v0, v1, WSF(WS_ROPEA) + (row * 64 + (cw >> 1)) * 2);
                            EGAS bf16_t* O = pn < 6 ? WSB(WS_QA) : WSB(WS_KA); const int c = (pn < 6 ? pn : pn - 6) * 256 + ct;
                            st8(O + row * WA + c, v0, v1);
                        } else if (pn < 18) { st8(WSB(WS_VA) + row * WA + (pn - 12) * 256 + ct, v0, v1);
                        } else if (pn < 20) { st8(WSB(WS_QL) + row * QLORA + (pn - 18) * 256 + ct, v0, v1);
                        } else if (pn < 22) { st8(WSB(WS_KVL) + row * KVLORA + (pn - 20) * 256 + ct, v0, v1);
                        } else if (pn < 38) {
                            const int gc = (pn - 22) * 256 + ct; const EGAS float* bg = (const EGAS float*)p.f0; const f32x4 b0 = *(const EGAS f32x4*)(bg + gc), b1 = *(const EGAS f32x4*)(bg + gc + 4);
#pragma unroll
                            for (int e = 0; e < 4; ++e) { v0[e] = sigm(v0[e] + b0[e]); v1[e] = sigm(v1[e] + b1[e]); }
                            st8f8(WS8(WS_GATES) + row * 4096 + gc, v0, v1);
                        } else {
                            if (bj == 0 && wc < 2) { rope8(v0, v1, WSF(WS_ROPEB) + (row * 32 + (cw >> 1)) * 2); st8f8(WS8(WS_KPE) + row * 64 + cw, v0, v1); }
                        }
                    } else if constexpr (MODE == EP_CQ) {
                        constexpr float QS = 8.f * 0.07216878364870323f * 1.4426950408889634f;
                        if (pn < 8) { st8f8(WS8(WS_QB) + row * 3072 + (pn * 2 + bj) * 192 + cw, v0 * QS, v1 * QS); }
                        else { const int head = (pn - 8) * 4 + bj * 2 + (wc >> 1), loc = (wc & 1) * 32 + 8 * fq;
                            rope8(v0, v1, WSF(WS_ROPEB) + (row * 32 + (loc >> 1)) * 2); st8f8(WS8(WS_QB) + row * 3072 + head * 192 + 128 + loc, v0 * QS, v1 * QS); }
                    } else if constexpr (MODE == EP_CKV) {
                        if (bj == 0) st8f8(WS8(WS_KN) + row * 2048 + pn * 128 + cw, v0, v1);
                        else {
                            const unsigned t = row >> 6, k5 = row & 31u, pos = ((k5 >> 2) & 1u) * 32u + ((row >> 5) & 1u) * 16u + ((k5 & 3u) | ((k5 >> 3) << 2));
                            EGAS unsigned char* vt = WS8(WS_VB) + ((size_t)(pn * (S_ / 64) + t) * 128 + cw) * 64 + pos;
                            const int w0 = __builtin_amdgcn_cvt_pk_fp8_f32(v0[0], v0[1], 0, false), w1 = __builtin_amdgcn_cvt_pk_fp8_f32(v0[2], v0[3], 0, false);
                            const int w2 = __builtin_amdgcn_cvt_pk_fp8_f32(v1[0], v1[1], 0, false), w3 = __builtin_amdgcn_cvt_pk_fp8_f32(v1[2], v1[3], 0, false);
                            vt[0] = (unsigned char)w0; vt[64] = (unsigned char)(w0 >> 8); vt[128] = (unsigned char)w1; vt[192] = (unsigned char)(w1 >> 8);
                            vt[256] = (unsigned char)w2; vt[320] = (unsigned char)(w2 >> 8); vt[384] = (unsigned char)w3; vt[448] = (unsigned char)(w3 >> 8); }
                    } else if constexpr (MODE == EP_YA) {
                        const int c = pn * 256 + ct; f32x4 g0, g1; ld8f8(WS8(WS_GATES) + row * 4096 + c, g0, g1);
                        st8(WSB(WS_T) + row * 2048 + c, v0 * g0, v1 * g1);
                    } else if constexpr (MODE == EP_YB) {
                        const int c = pn * 256 + ct; f32x4 g0, g1, t0, t1; ld8f8(WS8(WS_GATES) + row * 4096 + 2048 + c, g0, g1); ld8(WSB(WS_T) + row * 2048 + c, t0, t1);
                        st8(WSB(WS_MERGED) + row * 2048 + c, t0 + v0 * g0, t1 + v1 * g1);
                    } else if constexpr (MODE == EP_RES) {
                        const int c = pn * 256 + ct; EGAS bf16_t* xb = (EGAS bf16_t*)((EGAS unsigned char*)p.fo + 67108864) + row * 2048 + c; f32x4 x0, x1;
                        if (p.f0) { const EGAS float* xi = (const EGAS float*)p.f0 + row * 2048 + c; x0 = *(const EGAS f32x4*)xi; x1 = *(const EGAS f32x4*)(xi + 4); } else ld8(xb, x0, x1);
                        st8(xb, x0 + v0, x1 + v1);
                    } else {
                        st8nt(WSB(WS_U) + row * 11264 + pn * 256 + ct, v0, v1);
                    }
                }
            }
    }
};
template <class Epi, class Sched, bool ALIGN_EPI = false, bool SP2 = false>
__device__ __forceinline__ void gemm_phase(PG8_LAS unsigned char* lds, const Gemm g, const Sched& S, const Epi& E) {
    int tid_ = threadIdx.x; asm volatile("" : "+v"(tid_));
    const int tid = tid_, wid = __builtin_amdgcn_readfirstlane(tid >> 6), lane = tid & 63, wr = wid >> 2, wc = wid & 3, fr = lane & 15, fq = lane >> 4;
    const int K = g.K, nt = K / BK;
    unsigned voffA[2], voffB[2];
#pragma unroll
    for (int i = 0; i < 2; ++i) { int R, C; stage_rc(tid * 16 + i * 8192, R, C); const int Rb = Epi::PERM ? ((R & ~31) + perm32(R & 31)) : R;
        voffA[i] = (unsigned)(R * K + C) * 2u; voffB[i] = (unsigned)(Rb * K + C) * 2u; }
    const size_t kstep = (size_t)(BK * 2);
    const size_t hstep = (size_t)HALF * K * 2;
    const size_t tstep = 2 * hstep;
    const unsigned ldsw = (unsigned)wid * 1024u;
    const int aoff = lds_byte(wr * 64 + fr, fq * 8), boff = lds_byte(wc * 32 + fr, fq * 8);
#define PG8_SA(b, h) (((b) * 2 + (h)) * HTB)
#define PG8_SB(b, h) ((4 + (b) * 2 + (h)) * HTB)
#define PG8_STAGE(bufoff, gbase, voff) do { _Pragma("unroll") for (int _i = 0; _i < 2; ++_i) \
        __builtin_amdgcn_global_load_lds((const unsigned*)((const char*)(gbase) + (voff)[_i]), (PG8_LAS unsigned*)(lds + (bufoff) + ldsw + _i * 8192), 16, 0, 0); } while (0)
#define PG8_LDA(dst, b, h) do { _Pragma("unroll") for (int m = 0; m < 4; ++m) _Pragma("unroll") for (int k = 0; k < 2; ++k) dst[m][k] = *(const PG8_LAS bf16x8*)(lds + PG8_SA(b, h) + aoff + m * 2048 + k * 1024); } while (0)
#define PG8_LDB(dst, b, h) do { _Pragma("unroll") for (int n = 0; n < 2; ++n) _Pragma("unroll") for (int k = 0; k < 2; ++k) dst[n][k] = *(const PG8_LAS bf16x8*)(lds + PG8_SB(b, h) + boff + n * 2048 + k * 1024); } while (0)
#define PG8_MMA(ai, bj, At, Bt) do { __builtin_amdgcn_s_setprio(1); _Pragma("unroll") for (int m = 0; m < 4; ++m) _Pragma("unroll") for (int n = 0; n < 2; ++n) _Pragma("unroll") for (int k = 0; k < 2; ++k) \
        acc[ai][bj][m][n] = __builtin_amdgcn_mfma_f32_16x16x32_bf16(Bt[n][k], At[m][k], acc[ai][bj][m][n], 0, 0, 0); __builtin_amdgcn_s_setprio(0); } while (0)
#define PG8_WAIT_V(n) asm volatile("s_waitcnt vmcnt(" #n ")" ::: "memory")
#define PG8_WAIT_L(n) asm volatile("s_waitcnt lgkmcnt(" #n ")" ::: "memory")
#define PG8_BAR __builtin_amdgcn_s_barrier()
#define PG8_SCHED __builtin_amdgcn_sched_barrier(0)
    Unit cur, nxt; int ui = 0;
    if (!S.next(0, cur)) return;
    f32x4 acc[2][2][4][2];
#pragma unroll
    for (int a = 0; a < 2; ++a)
#pragma unroll
        for (int b = 0; b < 2; ++b)
#pragma unroll
            for (int m = 0; m < 4; ++m)
#pragma unroll
                for (int n = 0; n < 2; ++n) acc[a][b][m][n] = (f32x4){0.f, 0.f, 0.f, 0.f};
    bf16x8 At[4][2], B0[2][2], B1[2][2];
    const char* cA = (const char*)g.A + (size_t)cur.pm * tstep; const char* cB = (const char*)g.Bt + (size_t)cur.pn * tstep;
    S.a_ready(cur);
    if constexpr (SP2) {
        PG8_STAGE(PG8_SB(0, 0), cB, voffB); PG8_STAGE(PG8_SB(0, 1), cB + hstep, voffB); PG8_STAGE(PG8_SA(0, 0), cA, voffA); PG8_STAGE(PG8_SA(0, 1), cA + hstep, voffA);
        if (wr == 1) PG8_BAR;
        PG8_WAIT_V(2); PG8_BAR;
        PG8_STAGE(PG8_SB(1, 0), cB + kstep, voffB); PG8_STAGE(PG8_SA(1, 0), cA + kstep, voffA); PG8_STAGE(PG8_SB(1, 1), cB + hstep + kstep, voffB);
        PG8_WAIT_V(6); PG8_BAR;
    } else {
        PG8_STAGE(PG8_SB(0, 0), cB, voffB); PG8_STAGE(PG8_SA(0, 0), cA, voffA); PG8_STAGE(PG8_SB(0, 1), cB + hstep, voffB); PG8_STAGE(PG8_SA(0, 1), cA + hstep, voffA);
        if (wr == 1) PG8_BAR;
        PG8_WAIT_V(4); PG8_BAR;
        PG8_STAGE(PG8_SB(1, 0), cB + kstep, voffB); PG8_STAGE(PG8_SA(1, 0), cA + kstep, voffA); PG8_STAGE(PG8_SB(1, 1), cB + hstep + kstep, voffB);
        PG8_WAIT_V(6); PG8_BAR;
    }
    for (;;) {
        const bool has_next = S.next(ui + 1, nxt);
        const char* nA = has_next ? (const char*)g.A + (size_t)nxt.pm * tstep : cA; const char* nB = has_next ? (const char*)g.Bt + (size_t)nxt.pn * tstep : cB;
        for (int t = 0; t < nt; t += 2) {
            const bool last = (t == nt - 2);
            const char* a1 = cA + (size_t)(t + 1) * kstep;
            const char* a2 = last ? nA : cA + (size_t)(t + 2) * kstep; const char* b2 = last ? nB : cB + (size_t)(t + 2) * kstep;
            const char* a3 = a2 + kstep; const char* b3 = b2 + kstep;
            if (last && has_next) S.a_ready(nxt);
            if constexpr (SP2) {
            PG8_LDB(B0, 0, 0); PG8_LDB(B1, 0, 1); PG8_SCHED; PG8_LDA(At, 0, 0); PG8_STAGE(PG8_SA(1, 1), a1 + hstep, voffA);
            PG8_WAIT_V(8); PG8_WAIT_L(0); PG8_BAR; PG8_MMA(0, 0, At, B0); PG8_MMA(0, 1, At, B1); PG8_BAR; PG8_SCHED;
            PG8_LDA(At, 0, 1); PG8_STAGE(PG8_SB(0, 0), b2, voffB); PG8_STAGE(PG8_SB(0, 1), b2 + hstep, voffB); PG8_STAGE(PG8_SA(0, 0), a2, voffA);
            PG8_WAIT_V(8); PG8_WAIT_L(0); PG8_BAR; PG8_MMA(1, 0, At, B0); PG8_MMA(1, 1, At, B1); PG8_BAR; PG8_SCHED;
            PG8_LDB(B0, 1, 0); PG8_LDB(B1, 1, 1); PG8_SCHED; PG8_LDA(At, 1, 0); PG8_STAGE(PG8_SA(0, 1), a2 + hstep, voffA);
            PG8_WAIT_V(8); PG8_WAIT_L(0); PG8_BAR; PG8_MMA(0, 0, At, B0); PG8_MMA(0, 1, At, B1); PG8_BAR; PG8_SCHED;
            PG8_LDA(At, 1, 1); PG8_STAGE(PG8_SB(1, 0), b3, voffB); PG8_STAGE(PG8_SB(1, 1), b3 + hstep, voffB); PG8_STAGE(PG8_SA(1, 0), a3, voffA);
            PG8_WAIT_V(8); PG8_WAIT_L(0); PG8_BAR; PG8_MMA(1, 0, At, B0); PG8_MMA(1, 1, At, B1); PG8_BAR; PG8_SCHED;
            } else {
            PG8_LDB(B0, 0, 0); PG8_SCHED; PG8_LDA(At, 0, 0); PG8_STAGE(PG8_SA(1, 1), a1 + hstep, voffA);
            PG8_WAIT_L(8); PG8_BAR; PG8_WAIT_L(0); PG8_MMA(0, 0, At, B0); PG8_BAR; PG8_SCHED;
            PG8_LDB(B1, 0, 1); PG8_STAGE(PG8_SB(0, 0), b2, voffB);
            PG8_BAR; PG8_WAIT_L(0); PG8_MMA(0, 1, At, B1); PG8_BAR;
            PG8_LDA(At, 0, 1); PG8_STAGE(PG8_SA(0, 0), a2, voffA);
            PG8_BAR; PG8_WAIT_L(0); PG8_MMA(1, 0, At, B0); PG8_BAR; PG8_SCHED;
            PG8_STAGE(PG8_SB(0, 1), b2 + hstep, voffB);
            PG8_WAIT_V(6); PG8_BAR; PG8_MMA(1, 1, At, B1); PG8_BAR;
            PG8_LDB(B0, 1, 0); PG8_SCHED; PG8_LDA(At, 1, 0); PG8_STAGE(PG8_SA(0, 1), a2 + hstep, voffA);
            PG8_WAIT_L(8); PG8_BAR; PG8_WAIT_L(0); PG8_MMA(0, 0, At, B0); PG8_BAR; PG8_SCHED;
            PG8_LDB(B1, 1, 1); PG8_STAGE(PG8_SB(1, 0), b3, voffB);
            PG8_BAR; PG8_WAIT_L(0); PG8_MMA(0, 1, At, B1); PG8_BAR;
            PG8_LDA(At, 1, 1); PG8_STAGE(PG8_SA(1, 0), a3, voffA);
            PG8_BAR; PG8_WAIT_L(0); PG8_MMA(1, 0, At, B0); PG8_BAR; PG8_SCHED;
            PG8_STAGE(PG8_SB(1, 1), b3 + hstep, voffB);
            PG8_WAIT_V(6); PG8_BAR; PG8_MMA(1, 1, At, B1); PG8_BAR;
            }
        }
        if constexpr (ALIGN_EPI) { if (wr == 0) PG8_BAR; }
        if constexpr (!Epi::AFTER_DRAIN) { E(acc, cur, wr, wc, fr, fq); S.done(cur); }
        if (!has_next) break;
#pragma unroll
        for (int a = 0; a < 2; ++a)
#pragma unroll
            for (int b = 0; b < 2; ++b)
#pragma unroll
                for (int m = 0; m < 4; ++m)
#pragma unroll
                    for (int n = 0; n < 2; ++n) acc[a][b][m][n] = (f32x4){0.f, 0.f, 0.f, 0.f};
        cur = nxt; cA = nA; cB = nB; ++ui;
        if constexpr (ALIGN_EPI) { if (wr == 1) PG8_BAR; }
    }
    PG8_WAIT_V(0);
    if constexpr (!ALIGN_EPI) { if (wr == 0) PG8_BAR; }
    PG8_BAR;
    if constexpr (Epi::AFTER_DRAIN) { E.fused(acc, cur, wr, wc, fr, fq, lds, wid, lane); S.done(cur); }
#undef PG8_SA
#undef PG8_SB
#undef PG8_STAGE
#undef PG8_LDA
#undef PG8_LDB
#undef PG8_MMA
#undef PG8_WAIT_V
#undef PG8_WAIT_L
#undef PG8_BAR
#undef PG8_SCHED
}
}
namespace att {
typedef unsigned short bf16_t;
typedef short bf16x8 __attribute__((ext_vector_type(8)));
typedef short s16x4 __attribute__((ext_vector_type(4)));
typedef float f32x16 __attribute__((ext_vector_type(16)));
typedef unsigned u32x4 __attribute__((ext_vector_type(4)));
constexpr int SHM_V = 16384, SHM_K = 16384, SHM_KR = 8192;
constexpr int OFF_V = 0, OFF_K = 2 * SHM_V, OFF_KR = OFF_K + 2 * SHM_K, OFF_WS = OFF_KR + 2 * SHM_KR, ATT_LDS = OFF_WS + 8 * 64 * 4;
#ifndef ATT_SDEPTH
#define ATT_SDEPTH 2
#endif
constexpr int SDEPTH = ATT_SDEPTH;
#define KSWZ(row, colB) ((row) * 256 + ((colB) ^ (((row) & 15) << 4)))
#define KRSWZ(row, colB) ((row) * 128 + ((colB) ^ ((((row) >> 1) & 7) << 4)))
#define SBAR() __builtin_amdgcn_sched_barrier(0)
__device__ __forceinline__ int crow(int r, int hi) { return (r & 3) + 8 * (r >> 2) + 4 * hi; }
__device__ __forceinline__ unsigned cvtpk(float lo, float hi) { unsigned r; asm volatile("v_cvt_pk_bf16_f32 %0, %1, %2" : "=v"(r) : "v"(lo), "v"(hi)); return r; }

__device__ __forceinline__ void partialSM(f32x16& p0, f32x16& p1, float& m_reg, float& mn, float& alpha, const float C, const float thr_raw) {
  float pmax = p0[0];
#pragma unroll
  for (int r = 1; r < 16; ++r) pmax = fmaxf(pmax, p0[r]);
#pragma unroll
  for (int r = 0; r < 16; ++r) pmax = fmaxf(pmax, p1[r]);
  { auto rr = __builtin_amdgcn_permlane32_swap(__float_as_uint(pmax), __float_as_uint(pmax), false, false);
    pmax = fmaxf(__uint_as_float(rr[0]), __uint_as_float(rr[1])); }
  if (__builtin_expect(__all(pmax - m_reg <= thr_raw), 1)) { mn = m_reg; alpha = 1.f; }
  else { mn = fmaxf(m_reg, pmax); alpha = __builtin_amdgcn_exp2f((m_reg - mn) * C); m_reg = mn; }
  const float mnC = -mn * C;
#pragma unroll
  for (int r = 0; r < 16; ++r) p0[r] = fmaf(p0[r], C, mnC);
#pragma unroll
  for (int r = 0; r < 16; ++r) p1[r] = fmaf(p1[r], C, mnC);
#pragma unroll
  for (int r = 0; r < 16; ++r) p0[r] = __builtin_amdgcn_exp2f(p0[r]);
}
__device__ __forceinline__ void finishSM(f32x16& p0, f32x16& p1, float alpha, float& l_reg, bf16x8& pa0, bf16x8& pa1, bf16x8& pa2, bf16x8& pa3) {
#pragma unroll
  for (int r = 0; r < 16; ++r) p1[r] = __builtin_amdgcn_exp2f(p1[r]);
  float ps = 0;
#pragma unroll
  for (int r = 0; r < 16; ++r) ps += p0[r];
#pragma unroll
  for (int r = 0; r < 16; ++r) ps += p1[r];
  { auto rr = __builtin_amdgcn_permlane32_swap(__float_as_uint(ps), __float_as_uint(ps), false, false);
    ps = __uint_as_float(rr[0]) + __uint_as_float(rr[1]); }
  l_reg = l_reg * alpha + ps;
#define PK4(P, BASE, OUT) do { unsigned a0 = cvtpk(P[BASE + 0], P[BASE + 1]), a1 = cvtpk(P[BASE + 2], P[BASE + 3]);   \
    unsigned b0 = cvtpk(P[BASE + 4], P[BASE + 5]), b1 = cvtpk(P[BASE + 6], P[BASE + 7]);                              \
    auto r0 = __builtin_amdgcn_permlane32_swap(a0, b0, false, false); auto r1 = __builtin_amdgcn_permlane32_swap(a1, b1, false, false); \
    u32x4 w = {r0[0], r1[0], r0[1], r1[1]}; OUT = *reinterpret_cast<bf16x8*>(&w); } while (0)
  PK4(p0, 0, pa0); PK4(p0, 8, pa1); PK4(p1, 0, pa2); PK4(p1, 8, pa3);
#undef PK4
}
template <int NR>
__device__ __forceinline__ void qkt(f32x16& p0, f32x16& p1, const char* Ks, const char* Krs, const bf16x8* qr, int r32, int hi) {
  p0 = f32x16{}; p1 = f32x16{};
#pragma unroll
  for (int d0 = 0; d0 < 8; ++d0) { const int cb = (d0 * 16 + hi * 8) * 2;
    bf16x8 b0 = *reinterpret_cast<const bf16x8*>(Ks + KSWZ(r32, cb));
    bf16x8 b1 = *reinterpret_cast<const bf16x8*>(Ks + KSWZ(32 + r32, cb));
    p0 = __builtin_amdgcn_mfma_f32_32x32x16_bf16(b0, qr[d0], p0, 0, 0, 0);
    p1 = __builtin_amdgcn_mfma_f32_32x32x16_bf16(b1, qr[d0], p1, 0, 0, 0); if ((d0 & 3) == 3) SBAR(); }
#pragma unroll
  for (int d0 = 0; d0 < NR; ++d0) { const int cb = (d0 * 16 + hi * 8) * 2;
    bf16x8 b0 = *reinterpret_cast<const bf16x8*>(Krs + KRSWZ(r32, cb));
    bf16x8 b1 = *reinterpret_cast<const bf16x8*>(Krs + KRSWZ(32 + r32, cb));
    p0 = __builtin_amdgcn_mfma_f32_32x32x16_bf16(b0, qr[8 + d0], p0, 0, 0, 0);
    p1 = __builtin_amdgcn_mfma_f32_32x32x16_bf16(b1, qr[8 + d0], p1, 0, 0, 0); }
}
__device__ __forceinline__ void qkt_r(f32x16& p0, f32x16& p1, const char* Ks, const char* Krs, const bf16x8* qr, const char* qrl, int r32, int hi) {
  p0 = f32x16{}; p1 = f32x16{};
#pragma unroll
  for (int d0 = 0; d0 < 8; ++d0) { const int cb = (d0 * 16 + hi * 8) * 2;
    bf16x8 b0 = *reinterpret_cast<const bf16x8*>(Ks + KSWZ(r32, cb));
    bf16x8 b1 = *reinterpret_cast<const bf16x8*>(Ks + KSWZ(32 + r32, cb));
    p0 = __builtin_amdgcn_mfma_f32_32x32x16_bf16(b0, qr[d0], p0, 0, 0, 0);
    p1 = __builtin_amdgcn_mfma_f32_32x32x16_bf16(b1, qr[d0], p1, 0, 0, 0); }
#pragma unroll
  for (int d0 = 0; d0 < 4; ++d0) { const int cb = (d0 * 16 + hi * 8) * 2;
    bf16x8 b0 = *reinterpret_cast<const bf16x8*>(Krs + KRSWZ(r32, cb));
    bf16x8 b1 = *reinterpret_cast<const bf16x8*>(Krs + KRSWZ(32 + r32, cb));
    const bf16x8 q = *reinterpret_cast<const bf16x8*>(qrl + d0 * 1024);
    p0 = __builtin_amdgcn_mfma_f32_32x32x16_bf16(b0, q, p0, 0, 0, 0);
    p1 = __builtin_amdgcn_mfma_f32_32x32x16_bf16(b1, q, p1, 0, 0, 0); }
}
__device__ __forceinline__ void amask(f32x16& p0, f32x16& p1, int base) {
#pragma unroll
  for (int r = 0; r < 16; ++r) { const int d = base + (r & 3) + 8 * (r >> 2);
    if (d > 64 || d < -64) p0[r] = -30000.f;
    if (d + 32 > 64 || d + 32 < -64) p1[r] = -30000.f; }
}
__device__ __forceinline__ int v_st(int k, int c) { const int kk = (k & ~0xC) | ((k & 4) << 1) | ((k & 8) >> 1); return ((kk >> 3) * 4 + (c >> 5)) * 512 + ((kk & 7) * 32 + (c & 31)) * 2; }
__device__ __forceinline__ int v_rd_base(int lane) { return ((lane & 3) << 3) | (((lane >> 2) & 3) << 6) | (((lane >> 4) & 1) << 5) | (((lane >> 5) & 1) << 8); }
constexpr int v_rd_off(int d0, int ks, int half) { return d0 * 512 + ks * 4096 + half * 2048; }
template <int OFF> __device__ __forceinline__ s16x4 tr_read(int vb) {
  s16x4 r; asm volatile("ds_read_b64_tr_b16 %0, %1 offset:%2" : "=&v"(r) : "v"(vb), "i"(OFF) : "memory"); return r;
}
template <int D0> __device__ __forceinline__ void pv_one(f32x16& od, int vb, bf16x8 pa0, bf16x8 pa1, bf16x8 pa2, bf16x8 pa3) {
  const s16x4 l0 = tr_read<v_rd_off(D0, 0, 0)>(vb), h0 = tr_read<v_rd_off(D0, 0, 1)>(vb), l1 = tr_read<v_rd_off(D0, 1, 0)>(vb), h1 = tr_read<v_rd_off(D0, 1, 1)>(vb);
  const s16x4 l2 = tr_read<v_rd_off(D0, 2, 0)>(vb), h2 = tr_read<v_rd_off(D0, 2, 1)>(vb), l3 = tr_read<v_rd_off(D0, 3, 0)>(vb), h3 = tr_read<v_rd_off(D0, 3, 1)>(vb);
  asm volatile("s_waitcnt lgkmcnt(0)" ::: "memory"); SBAR();
#define PK(L, H) (bf16x8){L[0], L[1], L[2], L[3], H[0], H[1], H[2], H[3]}
  od = __builtin_amdgcn_mfma_f32_32x32x16_bf16(pa0, PK(l0, h0), od, 0, 0, 0);
  od = __builtin_amdgcn_mfma_f32_32x32x16_bf16(pa1, PK(l1, h1), od, 0, 0, 0);
  od = __builtin_amdgcn_mfma_f32_32x32x16_bf16(pa2, PK(l2, h2), od, 0, 0, 0);
  od = __builtin_amdgcn_mfma_f32_32x32x16_bf16(pa3, PK(l3, h3), od, 0, 0, 0);
#undef PK
}
__device__ __forceinline__ void pv_d0(f32x16* o, int vb, bf16x8 pa0, bf16x8 pa1, bf16x8 pa2, bf16x8 pa3) {
  pv_one<0>(o[0], vb, pa0, pa1, pa2, pa3); pv_one<1>(o[1], vb, pa0, pa1, pa2, pa3); pv_one<2>(o[2], vb, pa0, pa1, pa2, pa3); pv_one<3>(o[3], vb, pa0, pa1, pa2, pa3);
}
template <int NR, bool MASK>
__device__ __forceinline__ void attn_unit(const bf16_t* __restrict__ Qb, int ldq, const bf16_t* __restrict__ Kh, int ldk, const bf16_t* __restrict__ Krh,
                                          const bf16_t* __restrict__ Vh, int ldv, bf16_t* __restrict__ Ob, int ldo, float* __restrict__ lse, int ldlse,
                                          const int NT, const int qoff, const float C, const float thr_raw, const float scale, char* lds) {
  int tid_ = threadIdx.x; asm volatile("" : "+v"(tid_));
  const int tid = tid_, wid = __builtin_amdgcn_readfirstlane(tid >> 6), lane = tid & 63, r32 = lane & 31, hi = lane >> 5;
  char* V_lds = lds + OFF_V; char* K_lds = lds + OFF_K; char* Kr_lds = lds + OFF_KR;
  float* ws = (float*)(lds + OFF_WS) + wid * 64; float* li_l = ws; float* al_l = ws + 32;
  float m_reg = MASK ? -30000.f : -1e30f, l_reg = 0; f32x16 o[4] = {}; bf16x8 qr[8 + NR];
  { const bf16_t* Qw = Qb + (unsigned)((wid * 32 + r32) * ldq + hi * 8);
#pragma unroll
    for (int d0 = 0; d0 < 8 + NR; ++d0) qr[d0] = *reinterpret_cast<const bf16x8*>(Qw + d0 * 16); }
  const int sr = tid >> 4, sc = (tid & 15) * 8, vst0 = v_st(sr, sc), vst1 = v_st(32 + sr, sc);
  const int krr = tid >> 3, krc = tid & 7, krst = KRSWZ(krr, krc * 16);
  const int vb0 = (int)(uintptr_t)V_lds + v_rd_base(lane);
  const int mbase = 4 * hi - (qoff + wid * 32 + r32);
  unsigned voff = (unsigned)(sr * ldv + sc), koff = (unsigned)(sr * ldk + sc), kroff = (unsigned)(krr * 64 + krc * 8);
  bf16x8 vs0, vs1, ks0, ks1, kr;
#define SLOAD() do { vs0 = *(const bf16x8*)(Vh + voff); vs1 = *(const bf16x8*)(Vh + voff + 32u * (unsigned)ldv); \
    ks0 = *(const bf16x8*)(Kh + koff); ks1 = *(const bf16x8*)(Kh + koff + 32u * (unsigned)ldk); \
    if constexpr (NR > 0) { kr = *(const bf16x8*)(Krh + kroff); kroff += 64u * 64u; } voff += 64u * (unsigned)ldv; koff += 64u * (unsigned)ldk; } while (0)
#define SWRITE(b) do { *(bf16x8*)(V_lds + (b) * SHM_V + vst0) = vs0; *(bf16x8*)(V_lds + (b) * SHM_V + vst1) = vs1; const int kc = sc * 2;  \
    *(bf16x8*)(K_lds + (b) * SHM_K + KSWZ(sr, kc)) = ks0; *(bf16x8*)(K_lds + (b) * SHM_K + KSWZ(32 + sr, kc)) = ks1; \
    if constexpr (NR > 0) *(bf16x8*)(Kr_lds + (b) * SHM_KR + krst) = kr; } while (0)
  f32x16 p0, p1; float mn, al; bf16x8 pa0, pa1, pa2, pa3;
  SLOAD(); SWRITE(0); __syncthreads();
  for (int j = 0; j < NT; ++j) {
    const int b = j & 1;
    if (j + 1 < NT) SLOAD();
    SBAR();
    bool live = true;
    if constexpr (MASK) { const int qlo = qoff + wid * 32, klo = 64 * j; live = !(klo > qlo + 31 + 64 || klo + 63 < qlo - 64); }
    if (live) {
    qkt<NR>(p0, p1, K_lds + b * SHM_K, Kr_lds + b * SHM_KR, qr, r32, hi);
    if constexpr (MASK) amask(p0, p1, 64 * j + mbase);
    partialSM(p0, p1, m_reg, mn, al, C, thr_raw);
    if (__any(al < 1.f)) { if (hi == 0) al_l[r32] = al; asm volatile("s_waitcnt lgkmcnt(0)" ::: "memory");
#pragma unroll
      for (int d = 0; d < 4; ++d)
#pragma unroll
        for (int r = 0; r < 16; ++r) o[d][r] *= al_l[crow(r, hi)]; }
    finishSM(p0, p1, al, l_reg, pa0, pa1, pa2, pa3); SBAR();
    pv_d0(o, vb0 + b * SHM_V, pa0, pa1, pa2, pa3);
    }
    SBAR();
    if (j + 1 < NT) SWRITE(b ^ 1);
    __syncthreads();
  }
  if (hi == 0) li_l[r32] = l_reg; asm volatile("s_waitcnt lgkmcnt(0)" ::: "memory");
  bf16_t* Ow = Ob + (unsigned)(wid * 32 * ldo + r32);
#pragma unroll
  for (int r = 0; r < 16; ++r) { const int orow = crow(r, hi); const float rl = __builtin_amdgcn_rcpf(li_l[orow]);
#pragma unroll
    for (int d0 = 0; d0 < 4; ++d0) Ow[(unsigned)(orow * ldo + d0 * 32)] = (bf16_t)(cvtpk(o[d0][r] * rl, 0.f) & 0xffffu); }
  if constexpr (MASK) { if (hi == 0) lse[(unsigned)((wid * 32 + r32) * ldlse)] = m_reg * scale + __logf(l_reg); }
  __syncthreads();
#undef SLOAD
#undef SWRITE
}

__device__ __forceinline__ void fakeSM(f32x16& p0, f32x16& p1, bf16x8& pa0, bf16x8& pa1, bf16x8& pa2, bf16x8& pa3) {
#define PK4(P, BASE, OUT) do { unsigned a0 = cvtpk(P[BASE + 0], P[BASE + 1]), a1 = cvtpk(P[BASE + 2], P[BASE + 3]);   \
    unsigned b0 = cvtpk(P[BASE + 4], P[BASE + 5]), b1 = cvtpk(P[BASE + 6], P[BASE + 7]);                              \
    auto r0 = __builtin_amdgcn_permlane32_swap(a0, b0, false, false); auto r1 = __builtin_amdgcn_permlane32_swap(a1, b1, false, false); \
    u32x4 w = {r0[0], r1[0], r0[1], r1[1]}; OUT = *reinterpret_cast<bf16x8*>(&w); } while (0)
  PK4(p0, 0, pa0); PK4(p0, 8, pa1); PK4(p1, 0, pa2); PK4(p1, 8, pa3);
#undef PK4
}
__device__ __forceinline__ void qkt_fake(f32x16& p0, f32x16& p1, const bf16x8* qr) {
  p0 = f32x16{}; p1 = f32x16{};
#pragma unroll
  for (int d0 = 0; d0 < 12; ++d0) { p0 = __builtin_amdgcn_mfma_f32_32x32x16_bf16(qr[(d0 + 1) & 7], qr[d0 & 7], p0, 0, 0, 0); p1 = __builtin_amdgcn_mfma_f32_32x32x16_bf16(qr[(d0 + 2) & 7], qr[d0 & 7], p1, 0, 0, 0); }
}
__device__ __forceinline__ void pv_fake(f32x16* o, bf16x8 pa0, bf16x8 pa1, bf16x8 pa2, bf16x8 pa3) {
#pragma unroll
  for (int d = 0; d < 4; ++d) { o[d] = __builtin_amdgcn_mfma_f32_32x32x16_bf16(pa0, pa1, o[d], 0, 0, 0); o[d] = __builtin_amdgcn_mfma_f32_32x32x16_bf16(pa1, pa2, o[d], 0, 0, 0);
    o[d] = __builtin_amdgcn_mfma_f32_32x32x16_bf16(pa2, pa3, o[d], 0, 0, 0); o[d] = __builtin_amdgcn_mfma_f32_32x32x16_bf16(pa3, pa0, o[d], 0, 0, 0); }
}
template <int NR, int FAKE = 0>
__device__ __forceinline__ void attn_unit2(const bf16_t* __restrict__ Qb, int ldq, const bf16_t* __restrict__ Kh, int ldk, const bf16_t* __restrict__ Krh,
                                           const bf16_t* __restrict__ Vh, int ldv, bf16_t* __restrict__ Ob, int ldo, const int NT, const float C, const float thr_raw, char* lds) {
  int tid_ = threadIdx.x; asm volatile("" : "+v"(tid_));
  const int tid = tid_, wid = tid >> 6, lane = tid & 63, r32 = lane & 31, hi = lane >> 5;
  char* V_lds = lds + OFF_V; char* K_lds = lds + OFF_K; char* Kr_lds = lds + OFF_KR;
  float* ws = (float*)(lds + OFF_WS) + wid * 64; float* li_l = ws; float* al_l = ws + 32;
  float m_reg = -1e30f, l_reg = 0; f32x16 o[4] = {}; bf16x8 qr[8];
  char* qrl = lds + ATT_LDS + wid * 4096 + lane * 16;
  { const bf16_t* Qw = Qb + (unsigned)((wid * 32 + r32) * ldq + hi * 8);
#pragma unroll
    for (int d0 = 0; d0 < 8; ++d0) qr[d0] = *reinterpret_cast<const bf16x8*>(Qw + d0 * 16);
#pragma unroll
    for (int d0 = 0; d0 < 4; ++d0) *reinterpret_cast<bf16x8*>(qrl + d0 * 1024) = *reinterpret_cast<const bf16x8*>(Qw + (8 + d0) * 16); }
  const int sr = tid >> 4, sc = (tid & 15) * 8, vst0 = v_st(sr, sc), kst0 = KSWZ(sr, sc * 2);
  const int krr = tid >> 3, krc = tid & 7, krst = KRSWZ(krr, krc * 16);
  const int vb0 = (int)(uintptr_t)V_lds + v_rd_base(lane);
  unsigned voff = (unsigned)(sr * ldv + sc), kroff = (unsigned)(krr * 64 + krc * 8);
  bf16x8 vs0, vs1, ks0, ks1, kr;
#define SLOAD() do { vs0 = *(const bf16x8*)(Vh + voff); vs1 = *(const bf16x8*)(Vh + voff + 32u * (unsigned)ldv); \
    ks0 = *(const bf16x8*)(Kh + voff); ks1 = *(const bf16x8*)(Kh + voff + 32u * (unsigned)ldv); \
    if constexpr (NR > 0) { kr = *(const bf16x8*)(Krh + kroff); kroff += 64u * 64u; } voff += 64u * (unsigned)ldv; } while (0)
#define SWRITE(b) do { *(bf16x8*)(V_lds + (b) * SHM_V + vst0) = vs0; *(bf16x8*)(V_lds + (b) * SHM_V + vst0 + 8192) = vs1;  \
    *(bf16x8*)(K_lds + (b) * SHM_K + kst0) = ks0; *(bf16x8*)(K_lds + (b) * SHM_K + kst0 + 8192) = ks1; \
    if constexpr (NR > 0) *(bf16x8*)(Kr_lds + (b) * SHM_KR + krst) = kr; } while (0)
#define RESC(a) do { if (__any((a) < 1.f)) { if (hi == 0) al_l[r32] = (a); asm volatile("s_waitcnt lgkmcnt(0)" ::: "memory"); \
    _Pragma("unroll") for (int d = 0; d < 4; ++d) _Pragma("unroll") for (int r = 0; r < 16; ++r) o[d][r] *= al_l[crow(r, hi)]; } } while (0)
  f32x16 pA0, pA1, pB0, pB1; float mnA, mnB, alA = 1.f, alB = 1.f; bf16x8 pa0, pa1, pa2, pa3;
#define QKT_A(K, KR) do { if constexpr (FAKE >= 2) qkt_fake(pA0, pA1, qr); else qkt_r(pA0, pA1, K, KR, qr, qrl, r32, hi); } while (0)
#define QKT_B(K, KR) do { if constexpr (FAKE >= 2) qkt_fake(pB0, pB1, qr); else qkt_r(pB0, pB1, K, KR, qr, qrl, r32, hi); } while (0)
#define PSM(P0, P1, MN, AL) do { if constexpr (FAKE == 0) partialSM(P0, P1, m_reg, MN, AL, C, thr_raw); } while (0)
#define FSM(P0, P1, AL) do { if constexpr (FAKE == 0) finishSM(P0, P1, AL, l_reg, pa0, pa1, pa2, pa3); else fakeSM(P0, P1, pa0, pa1, pa2, pa3); } while (0)
#define PVD(VB) do { if constexpr (FAKE >= 3) pv_fake(o, pa0, pa1, pa2, pa3); else pv_d0(o, VB, pa0, pa1, pa2, pa3); } while (0)
  SLOAD(); SWRITE(0); __syncthreads();
  SLOAD();
  QKT_A(K_lds, Kr_lds); PSM(pA0, pA1, mnA, alA);
  SWRITE(1); __syncthreads();
  for (int j = 1; j + 1 < NT; j += 2) {
    SLOAD(); SBAR();
    QKT_B(K_lds + SHM_K, Kr_lds + SHM_KR);
    FSM(pA0, pA1, alA); SBAR();
    PVD(vb0); PSM(pB0, pB1, mnB, alB);
    __syncthreads(); SWRITE(0);
    RESC(alB); __syncthreads();
    if (j + 2 < NT) SLOAD();
    SBAR();
    QKT_A(K_lds, Kr_lds);
    FSM(pB0, pB1, alB); SBAR();
    PVD(vb0 + SHM_V); PSM(pA0, pA1, mnA, alA);
    __syncthreads(); if (j + 2 < NT) SWRITE(1);
    RESC(alA); __syncthreads();
  }
  SBAR(); QKT_B(K_lds + SHM_K, Kr_lds + SHM_KR);
  FSM(pA0, pA1, alA); SBAR();
  PVD(vb0); PSM(pB0, pB1, mnB, alB);
  RESC(alB);
  FSM(pB0, pB1, alB); SBAR();
  PVD(vb0 + SHM_V);
  if constexpr (FAKE != 0) l_reg = 1.f;
  if (hi == 0) li_l[r32] = l_reg; asm volatile("s_waitcnt lgkmcnt(0)" ::: "memory");
  bf16_t* Ow = Ob + (unsigned)(wid * 32 * ldo + r32);
#pragma unroll
  for (int r = 0; r < 16; ++r) { const int orow = crow(r, hi); const float rl = __builtin_amdgcn_rcpf(li_l[orow]);
#pragma unroll
    for (int d0 = 0; d0 < 4; ++d0) Ow[(unsigned)(orow * ldo + d0 * 32)] = (bf16_t)(cvtpk(o[d0][r] * rl, 0.f) & 0xffffu); }
  __syncthreads();
#undef SLOAD
#undef SWRITE
#undef RESC
#undef QKT_A
#undef QKT_B
#undef PSM
#undef FSM
#undef PVD
}
typedef int v8i32 __attribute__((ext_vector_type(8)));
typedef int v4i32 __attribute__((ext_vector_type(4)));
constexpr int F8_V = 0, F8_KN = 2 * 16384, F8_KR = F8_KN + 2 * 8192, F8_WS = F8_KR + 2 * 4096, F8_LDS = F8_WS + 8 * 64 * 4;
#define KN8SW(row, chunk) ((row) * 128 + ((((chunk)) ^ (((row) >> 1) & 7)) << 4))
#define KR8SW(row, chunk) ((row) * 64 + ((((chunk)) ^ (((row) >> 2) & 3)) << 4))
__device__ __forceinline__ v8i32 cat8(v4i32 a, v4i32 b) { return (v8i32){a[0], a[1], a[2], a[3], b[0], b[1], b[2], b[3]}; }
__device__ __forceinline__ void qkt8(f32x16& p0, f32x16& p1, const char* Kn, const char* Kr, const v8i32* qf, int r32, int hi) {
  p0 = f32x16{}; p1 = f32x16{};
#pragma unroll
  for (int s = 0; s < 2; ++s) { const int c0 = s * 4 + hi * 2;
    const v8i32 a0 = cat8(*reinterpret_cast<const v4i32*>(Kn + KN8SW(r32, c0)), *reinterpret_cast<const v4i32*>(Kn + KN8SW(r32, c0 + 1)));
    const v8i32 a1 = cat8(*reinterpret_cast<const v4i32*>(Kn + 4096 + KN8SW(r32, c0)), *reinterpret_cast<const v4i32*>(Kn + 4096 + KN8SW(r32, c0 + 1)));
    p0 = __builtin_amdgcn_mfma_scale_f32_32x32x64_f8f6f4(a0, qf[s], p0, 0, 0, 0, 127, 0, 127);
    p1 = __builtin_amdgcn_mfma_scale_f32_32x32x64_f8f6f4(a1, qf[s], p1, 0, 0, 0, 127, 0, 127); }
  { const int c0 = hi * 2;
    const v8i32 a0 = cat8(*reinterpret_cast<const v4i32*>(Kr + KR8SW(r32, c0)), *reinterpret_cast<const v4i32*>(Kr + KR8SW(r32, c0 + 1)));
    const v8i32 a1 = cat8(*reinterpret_cast<const v4i32*>(Kr + 2048 + KR8SW(r32, c0)), *reinterpret_cast<const v4i32*>(Kr + 2048 + KR8SW(r32, c0 + 1)));
    p0 = __builtin_amdgcn_mfma_scale_f32_32x32x64_f8f6f4(a0, qf[2], p0, 0, 0, 0, 127, 0, 127);
    p1 = __builtin_amdgcn_mfma_scale_f32_32x32x64_f8f6f4(a1, qf[2], p1, 0, 0, 0, 127, 0, 127); }
}
__device__ __forceinline__ void attn_unit6(const unsigned char* __restrict__ Q8, int ldq, const unsigned char* __restrict__ Kn8, int ldk, const unsigned char* __restrict__ Kr8,
                                           const bf16_t* __restrict__ Vh, int ldv, bf16_t* __restrict__ Ob, int ldo, const int NT, const float C, const float thr_raw, char* lds) {
  int tid_ = threadIdx.x; asm volatile("" : "+v"(tid_));
  const int tid = tid_, wid = tid >> 6, lane = tid & 63, r32 = lane & 31, hi = lane >> 5;
  char* V_lds = lds + F8_V; char* Kn_lds = lds + F8_KN; char* Kr_lds = lds + F8_KR;
  float* ws = (float*)(lds + F8_WS) + wid * 64; float* li_l = ws; float* al_l = ws + 32;
  float m_reg = -1e30f, l_reg = 0; f32x16 o[4] = {}; v8i32 qf[3];
  { const unsigned char* Qw = Q8 + (unsigned)((wid * 32 + r32) * ldq + hi * 32);
#pragma unroll
    for (int s = 0; s < 3; ++s) qf[s] = cat8(*reinterpret_cast<const v4i32*>(Qw + s * 64), *reinterpret_cast<const v4i32*>(Qw + s * 64 + 16)); }
  const int sr = tid >> 4, sc = (tid & 15) * 8, vst0 = v_st(sr, sc);
  const int knr = tid >> 3, knc = tid & 7, knst = KN8SW(knr, knc);
  const int krr = (tid >> 2) & 63, krc = tid & 3, krst = KR8SW(krr, krc);
  const bool krw = tid < 256;
  const int vb0 = (int)(uintptr_t)V_lds + v_rd_base(lane);
  unsigned voff = (unsigned)(sr * ldv + sc), knoff = (unsigned)(knr * ldk + knc * 16), kroff = (unsigned)(krr * 64 + krc * 16);
  bf16x8 vs0, vs1; v4i32 kn, kr;
#define SLOAD() do { vs0 = *(const bf16x8*)(Vh + voff); vs1 = *(const bf16x8*)(Vh + voff + 32u * (unsigned)ldv); kn = *(const v4i32*)(Kn8 + knoff); \
    if (krw) kr = *(const v4i32*)(Kr8 + kroff); voff += 64u * (unsigned)ldv; knoff += 64u * (unsigned)ldk; kroff += 64u * 64u; } while (0)
#define SWRITE(b) do { *(bf16x8*)(V_lds + (b) * 16384 + vst0) = vs0; *(bf16x8*)(V_lds + (b) * 16384 + vst0 + 8192) = vs1;  \
    *(v4i32*)(Kn_lds + (b) * 8192 + knst) = kn; if (krw) *(v4i32*)(Kr_lds + (b) * 4096 + krst) = kr; } while (0)
#define RESC(a) do { if (__any((a) < 1.f)) { if (hi == 0) al_l[r32] = (a); asm volatile("s_waitcnt lgkmcnt(0)" ::: "memory"); \
    _Pragma("unroll") for (int d = 0; d < 4; ++d) _Pragma("unroll") for (int r = 0; r < 16; ++r) o[d][r] *= al_l[crow(r, hi)]; } } while (0)
  f32x16 pA0, pA1, pB0, pB1; float mnA, mnB, alA, alB; bf16x8 pa0, pa1, pa2, pa3;
  SLOAD(); SWRITE(0); __syncthreads();
  SLOAD();
  qkt8(pA0, pA1, Kn_lds, Kr_lds, qf, r32, hi); partialSM(pA0, pA1, m_reg, mnA, alA, C, thr_raw);
  SWRITE(1); __syncthreads();
  for (int j = 1; j + 1 < NT; j += 2) {
    SLOAD(); SBAR();
    qkt8(pB0, pB1, Kn_lds + 8192, Kr_lds + 4096, qf, r32, hi);
    finishSM(pA0, pA1, alA, l_reg, pa0, pa1, pa2, pa3); SBAR();
    pv_d0(o, vb0, pa0, pa1, pa2, pa3); partialSM(pB0, pB1, m_reg, mnB, alB, C, thr_raw);
    __syncthreads(); SWRITE(0);
    RESC(alB); __syncthreads();
    if (j + 2 < NT) SLOAD();
    SBAR();
    qkt8(pA0, pA1, Kn_lds, Kr_lds, qf, r32, hi);
    finishSM(pB0, pB1, alB, l_reg, pa0, pa1, pa2, pa3); SBAR();
    pv_d0(o, vb0 + 16384, pa0, pa1, pa2, pa3); partialSM(pA0, pA1, m_reg, mnA, alA, C, thr_raw);
    __syncthreads(); if (j + 2 < NT) SWRITE(1);
    RESC(alA); __syncthreads();
  }
  SBAR(); qkt8(pB0, pB1, Kn_lds + 8192, Kr_lds + 4096, qf, r32, hi);
  finishSM(pA0, pA1, alA, l_reg, pa0, pa1, pa2, pa3); SBAR();
  pv_d0(o, vb0, pa0, pa1, pa2, pa3); partialSM(pB0, pB1, m_reg, mnB, alB, C, thr_raw);
  RESC(alB);
  finishSM(pB0, pB1, alB, l_reg, pa0, pa1, pa2, pa3); SBAR();
  pv_d0(o, vb0 + 16384, pa0, pa1, pa2, pa3);
  if (hi == 0) li_l[r32] = l_reg; asm volatile("s_waitcnt lgkmcnt(0)" ::: "memory");
  bf16_t* Ow = Ob + (unsigned)(wid * 32 * ldo + r32);
#pragma unroll
  for (int r = 0; r < 16; ++r) { const int orow = crow(r, hi); const float rl = __builtin_amdgcn_rcpf(li_l[orow]);
#pragma unroll
    for (int d0 = 0; d0 < 4; ++d0) Ow[(unsigned)(orow * ldo + d0 * 32)] = (bf16_t)(cvtpk(o[d0][r] * rl, 0.f) & 0xffffu); }
  __syncthreads();
#undef SLOAD
#undef SWRITE
#undef RESC
}
constexpr int G8_VT = 0, G8_KN = 2 * 8192, G8_KR = G8_KN + 2 * 8192, G8_WS = G8_KR + 2 * 4096, G8_LDS = G8_WS + 8 * 64 * 4;
__device__ __forceinline__ void partialSM8(f32x16& p0, f32x16& p1, float& m_reg, float& alpha, const float C, const float thr_raw) {
  float pmax = p0[0];
#pragma unroll
  for (int r = 1; r < 16; ++r) pmax = fmaxf(pmax, p0[r]);
#pragma unroll
  for (int r = 0; r < 16; ++r) pmax = fmaxf(pmax, p1[r]);
  { auto rr = __builtin_amdgcn_permlane32_swap(__float_as_uint(pmax), __float_as_uint(pmax), false, false);
    pmax = fmaxf(__uint_as_float(rr[0]), __uint_as_float(rr[1])); }
  float mn;
  if (__builtin_expect(__all(pmax - m_reg <= thr_raw), 1)) { mn = m_reg; alpha = 1.f; }
  else { mn = fmaxf(m_reg, pmax); alpha = __builtin_amdgcn_exp2f((m_reg - mn) * C); m_reg = mn; }
  const float mnC = 7.0f - mn * C;
#pragma unroll
  for (int r = 0; r < 16; ++r) p0[r] = fmaf(p0[r], C, mnC);
#pragma unroll
  for (int r = 0; r < 16; ++r) p1[r] = fmaf(p1[r], C, mnC);
#pragma unroll
  for (int r = 0; r < 16; ++r) p0[r] = __builtin_amdgcn_exp2f(p0[r]);
}
__device__ __forceinline__ void finishSM8(f32x16& p0, f32x16& p1, float alpha, float& l_reg, v8i32& p8) {
#pragma unroll
  for (int r = 0; r < 16; ++r) p1[r] = __builtin_amdgcn_exp2f(p1[r]);
  float ps = 0;
#pragma unroll
  for (int r = 0; r < 16; ++r) ps += p0[r];
#pragma unroll
  for (int r = 0; r < 16; ++r) ps += p1[r];
  { auto rr = __builtin_amdgcn_permlane32_swap(__float_as_uint(ps), __float_as_uint(ps), false, false);
    ps = __uint_as_float(rr[0]) + __uint_as_float(rr[1]); }
  l_reg = l_reg * alpha + ps;
#pragma unroll
  for (int g = 0; g < 4; ++g) {
    int w = __builtin_amdgcn_cvt_pk_fp8_f32(p0[4 * g], p0[4 * g + 1], 0, false); p8[g] = __builtin_amdgcn_cvt_pk_fp8_f32(p0[4 * g + 2], p0[4 * g + 3], w, true);
    int u = __builtin_amdgcn_cvt_pk_fp8_f32(p1[4 * g], p1[4 * g + 1], 0, false); p8[4 + g] = __builtin_amdgcn_cvt_pk_fp8_f32(p1[4 * g + 2], p1[4 * g + 3], u, true); }
}
__device__ __forceinline__ void finishSM9(f32x16& p0, f32x16& p1, float alpha, float& l_reg, v8i32& p8) {
#pragma unroll
  for (int r = 0; r < 16; ++r) { p0[r] = __builtin_amdgcn_exp2f(p0[r]); p1[r] = __builtin_amdgcn_exp2f(p1[r]); }
  float ps = 0;
#pragma unroll
  for (int r = 0; r < 16; ++r) ps += p0[r];
#pragma unroll
  for (int r = 0; r < 16; ++r) ps += p1[r];
  { auto rr = __builtin_amdgcn_permlane32_swap(__float_as_uint(ps), __float_as_uint(ps), false, false);
    ps = __uint_as_float(rr[0]) + __uint_as_float(rr[1]); }
  l_reg = l_reg * alpha + ps;
#pragma unroll
  for (int g = 0; g < 4; ++g) {
    int w = __builtin_amdgcn_cvt_pk_fp8_f32(p0[4 * g], p0[4 * g + 1], 0, false); p8[g] = __builtin_amdgcn_cvt_pk_fp8_f32(p0[4 * g + 2], p0[4 * g + 3], w, true);
    int u = __builtin_amdgcn_cvt_pk_fp8_f32(p1[4 * g], p1[4 * g + 1], 0, false); p8[4 + g] = __builtin_amdgcn_cvt_pk_fp8_f32(p1[4 * g + 2], p1[4 * g + 3], u, true); }
}
__device__ __forceinline__ void pv8(f32x16* o, const char* Vt, const v8i32 p8, int r32, int hi) {
  const int sw = (r32 >> 2) & 3, a0 = r32 * 64 + (((hi * 2) ^ sw) << 4), a1 = r32 * 64 + (((hi * 2 + 1) ^ sw) << 4);
#pragma unroll
  for (int d0 = 0; d0 < 4; ++d0) {
    const v8i32 vf = cat8(*reinterpret_cast<const v4i32*>(Vt + d0 * 2048 + a0), *reinterpret_cast<const v4i32*>(Vt + d0 * 2048 + a1));
    o[d0] = __builtin_amdgcn_mfma_scale_f32_32x32x64_f8f6f4(p8, vf, o[d0], 0, 0, 0, 127, 0, 127); }
}
__device__ __forceinline__ void qkt9(f32x16& p0, f32x16& p1, const char* Kn, const char* Kr, const v8i32* qf, const float init, int r32, int hi) {
#pragma unroll
  for (int r = 0; r < 16; ++r) { p0[r] = init; p1[r] = init; }
#pragma unroll
  for (int s = 0; s < 2; ++s) { const int c0 = s * 4 + hi * 2;
    const v8i32 a0 = cat8(*reinterpret_cast<const v4i32*>(Kn + KN8SW(r32, c0)), *reinterpret_cast<const v4i32*>(Kn + KN8SW(r32, c0 + 1)));
    const v8i32 a1 = cat8(*reinterpret_cast<const v4i32*>(Kn + 4096 + KN8SW(r32, c0)), *reinterpret_cast<const v4i32*>(Kn + 4096 + KN8SW(r32, c0 + 1)));
    p0 = __builtin_amdgcn_mfma_scale_f32_32x32x64_f8f6f4(a0, qf[s], p0, 0, 0, 0, 127, 0, 124);
    p1 = __builtin_amdgcn_mfma_scale_f32_32x32x64_f8f6f4(a1, qf[s], p1, 0, 0, 0, 127, 0, 124); }
  { const int c0 = hi * 2;
    const v8i32 a0 = cat8(*reinterpret_cast<const v4i32*>(Kr + KR8SW(r32, c0)), *reinterpret_cast<const v4i32*>(Kr + KR8SW(r32, c0 + 1)));
    const v8i32 a1 = cat8(*reinterpret_cast<const v4i32*>(Kr + 2048 + KR8SW(r32, c0)), *reinterpret_cast<const v4i32*>(Kr + 2048 + KR8SW(r32, c0 + 1)));
    p0 = __builtin_amdgcn_mfma_scale_f32_32x32x64_f8f6f4(a0, qf[2], p0, 0, 0, 0, 127, 0, 124);
    p1 = __builtin_amdgcn_mfma_scale_f32_32x32x64_f8f6f4(a1, qf[2], p1, 0, 0, 0, 127, 0, 124); }
}
__device__ __forceinline__ void partialSM9(f32x16& p0, f32x16& p1, float& m_run, float& alpha, const float thr2) {
  float pmax = p0[0];
#pragma unroll
  for (int r = 1; r < 16; ++r) pmax = fmaxf(pmax, p0[r]);
#pragma unroll
  for (int r = 0; r < 16; ++r) pmax = fmaxf(pmax, p1[r]);
  { auto rr = __builtin_amdgcn_permlane32_swap(__float_as_uint(pmax), __float_as_uint(pmax), false, false);
    pmax = fmaxf(__uint_as_float(rr[0]), __uint_as_float(rr[1])); }
  if (__builtin_expect(__all(pmax <= 7.0f + thr2), 1)) { alpha = 1.f; }
  else { const float delta = fmaxf(pmax - 7.0f, 0.f); alpha = __builtin_amdgcn_exp2f(-delta); m_run += delta;
#pragma unroll
    for (int r = 0; r < 16; ++r) { p0[r] -= delta; p1[r] -= delta; } }
}
__device__ __forceinline__ void attn_unit7(const unsigned char* __restrict__ Q8, int ldq, const unsigned char* __restrict__ Kn8, int ldk, const unsigned char* __restrict__ Kr8,
                                           const unsigned char* __restrict__ VT8, bf16_t* __restrict__ Ob, int ldo, const int NT, const float C, const float thr_raw, char* lds) {
  int tid_ = threadIdx.x; asm volatile("" : "+v"(tid_));
  const int tid = tid_, wid = tid >> 6, lane = tid & 63, r32 = lane & 31, hi = lane >> 5;
  char* Vt_lds = lds + G8_VT; char* Kn_lds = lds + G8_KN; char* Kr_lds = lds + G8_KR;
  float* ws = (float*)(lds + G8_WS) + wid * 64; float* li_l = ws; float* al_l = ws + 32;
  float m_reg = 0.f, l_reg = 0; f32x16 o[4] = {}; v8i32 qf[3];
  { const unsigned char* Qw = Q8 + (unsigned)((wid * 32 + r32) * ldq + hi * 32);
#pragma unroll
    for (int s = 0; s < 3; ++s) qf[s] = cat8(*reinterpret_cast<const v4i32*>(Qw + s * 64), *reinterpret_cast<const v4i32*>(Qw + s * 64 + 16)); }
  const int vtr = tid >> 2, vtc = tid & 3, vtst = vtr * 64 + ((vtc ^ ((vtr >> 2) & 3)) << 4);
  const int knr = tid >> 3, knc = tid & 7, knst = KN8SW(knr, knc);
  const int krr = (tid >> 2) & 63, krc = tid & 3, krst = KR8SW(krr, krc);
  const bool krw = tid < 256;
  unsigned vtoff = (unsigned)(tid * 16), knoff = (unsigned)(knr * ldk + knc * 16), kroff = (unsigned)(krr * 64 + krc * 16);
  v4i32 vt, kn, kr;
#define SLOAD() do { vt = *(const v4i32*)(VT8 + vtoff); kn = *(const v4i32*)(Kn8 + knoff); if (krw) kr = *(const v4i32*)(Kr8 + kroff); \
    vtoff += 8192u; knoff += 64u * (unsigned)ldk; kroff += 64u * 64u; } while (0)
#define SWRITE(b) do { *(v4i32*)(Vt_lds + (b) * 8192 + vtst) = vt; *(v4i32*)(Kn_lds + (b) * 8192 + knst) = kn; if (krw) *(v4i32*)(Kr_lds + (b) * 4096 + krst) = kr; } while (0)
#define RESC(a) do { if (__any((a) < 1.f)) { if (hi == 0) al_l[r32] = (a); asm volatile("s_waitcnt lgkmcnt(0)" ::: "memory"); \
    _Pragma("unroll") for (int d = 0; d < 4; ++d) _Pragma("unroll") for (int r = 0; r < 16; ++r) o[d][r] *= al_l[crow(r, hi)]; } } while (0)
  f32x16 pA0, pA1, pB0, pB1; float alA, alB; v8i32 p8;
  SLOAD(); SWRITE(0); __syncthreads();
  SLOAD();
  qkt9(pA0, pA1, Kn_lds, Kr_lds, qf, 7.0f - m_reg, r32, hi); partialSM9(pA0, pA1, m_reg, alA, thr_raw);
  SWRITE(1); __syncthreads();
  for (int j = 1; j + 1 < NT; j += 2) {
    SLOAD();
    qkt9(pB0, pB1, Kn_lds + 8192, Kr_lds + 4096, qf, 7.0f - m_reg, r32, hi);
    finishSM9(pA0, pA1, alA, l_reg, p8);
    pv8(o, Vt_lds, p8, r32, hi); partialSM9(pB0, pB1, m_reg, alB, thr_raw);
    __syncthreads(); SWRITE(0);
    RESC(alB); __syncthreads();
    if (j + 2 < NT) SLOAD();

    qkt9(pA0, pA1, Kn_lds, Kr_lds, qf, 7.0f - m_reg, r32, hi);
    finishSM9(pB0, pB1, alB, l_reg, p8);
    pv8(o, Vt_lds + 8192, p8, r32, hi); partialSM9(pA0, pA1, m_reg, alA, thr_raw);
    __syncthreads(); if (j + 2 < NT) SWRITE(1);
    RESC(alA); __syncthreads();
  }
  qkt9(pB0, pB1, Kn_lds + 8192, Kr_lds + 4096, qf, 7.0f - m_reg, r32, hi);
  finishSM9(pA0, pA1, alA, l_reg, p8);
  pv8(o, Vt_lds, p8, r32, hi); partialSM9(pB0, pB1, m_reg, alB, thr_raw);
  RESC(alB);
  finishSM9(pB0, pB1, alB, l_reg, p8);
  pv8(o, Vt_lds + 8192, p8, r32, hi);
  if (hi == 0) li_l[r32] = l_reg; asm volatile("s_waitcnt lgkmcnt(0)" ::: "memory");
  char* ost = lds + G8_LDS + wid * 8192;
#pragma unroll
  for (int r = 0; r < 16; ++r) { const int orow = crow(r, hi); const float rl = __builtin_amdgcn_rcpf(li_l[orow]);
#pragma unroll
    for (int d0 = 0; d0 < 4; ++d0) *(bf16_t*)(ost + orow * 256 + (d0 * 32 + r32) * 2) = (bf16_t)(cvtpk(o[d0][r] * rl, 0.f) & 0xffffu); }
  asm volatile("s_waitcnt lgkmcnt(0)" ::: "memory");
  { bf16_t* Og = Ob + (unsigned)(wid * 32 * ldo);
#pragma unroll
    for (int i = 0; i < 8; ++i) { const int q = i * 64 + lane, row = q >> 4, c16 = q & 15;
      *(u32x4*)(Og + (unsigned)(row * ldo + c16 * 8)) = *(const u32x4*)(ost + row * 256 + c16 * 16); } }
  __syncthreads();
#undef SLOAD
#undef SWRITE
#undef RESC
}
#define ALAS __attribute__((address_space(3)))
constexpr int R_K = 0, R_V = 3 * 16384, R_KR = 6 * 16384, R_WS = R_KR + 3 * 8192, ATT3_LDS = R_WS + 8 * 64 * 4;
__device__ __forceinline__ void attn_unit3(const bf16_t* __restrict__ Qb, int ldq, const bf16_t* __restrict__ Kh, const bf16_t* __restrict__ Krh, const bf16_t* __restrict__ Vh, int ldkv,
                                           bf16_t* __restrict__ Ob, int ldo, const int NT, const float C, const float thr_raw, ALAS char* lds) {
  int tid_ = threadIdx.x; asm volatile("" : "+v"(tid_));
  const int tid = tid_, wid = __builtin_amdgcn_readfirstlane(tid >> 6), lane = tid & 63, r32 = lane & 31, hi = lane >> 5;
  ALAS float* ws = (ALAS float*)(lds + R_WS) + wid * 64; ALAS float* li_l = ws; ALAS float* al_l = ws + 32;
  float m_reg = -1e30f, l_reg = 0; f32x16 o[4] = {}; bf16x8 qr[12];
  { const bf16_t* Qw = Qb + (unsigned)((wid * 32 + r32) * ldq + hi * 8);
#pragma unroll
    for (int d0 = 0; d0 < 12; ++d0) qr[d0] = *reinterpret_cast<const bf16x8*>(Qw + d0 * 16); }
  unsigned koA, koB, voA, voB, kro;
  { const int q0 = wid * 64 + lane, q1 = q0 + 512;
    koA = (unsigned)((q0 >> 4) * ldkv + (((q0 & 15) ^ ((q0 >> 4) & 15)) * 8)); koB = (unsigned)((q1 >> 4) * ldkv + (((q1 & 15) ^ ((q1 >> 4) & 15)) * 8));
    { const int st = q0 >> 5, kk = ((st >> 2) << 3) | ((q0 >> 2) & 7), k = (kk & ~0xC) | ((kk & 4) << 1) | ((kk & 8) >> 1), c = (st & 3) * 32 + (q0 & 3) * 8; voA = (unsigned)(k * ldkv + c); }
    { const int st = q1 >> 5, kk = ((st >> 2) << 3) | ((q1 >> 2) & 7), k = (kk & ~0xC) | ((kk & 4) << 1) | ((kk & 8) >> 1), c = (st & 3) * 32 + (q1 & 3) * 8; voB = (unsigned)(k * ldkv + c); }
    { const int r = q0 >> 3, cl = (q0 & 7) ^ ((r >> 1) & 7); kro = (unsigned)(r * 64 + cl * 8); } }
  const int vbl = (int)(unsigned)(__UINTPTR_TYPE__)lds + R_V + v_rd_base(lane);
  const int kl0 = r32 * 256, kx = ((r32 & 15) << 4), krl0 = r32 * 128, krx = (((r32 >> 1) & 7) << 4);
#define DMA(t, s) do { const bf16_t* kb_ = Kh + (size_t)(t) * 64 * ldkv; const bf16_t* vb_ = Vh + (size_t)(t) * 64 * ldkv; const bf16_t* rb_ = Krh + (size_t)(t) * 4096; \
    __builtin_amdgcn_global_load_lds((const unsigned*)(kb_ + koA), (ALAS unsigned*)(lds + R_K + (s) * 16384 + wid * 1024), 16, 0, 0); \
    __builtin_amdgcn_global_load_lds((const unsigned*)(kb_ + koB), (ALAS unsigned*)(lds + R_K + (s) * 16384 + 8192 + wid * 1024), 16, 0, 0); \
    __builtin_amdgcn_global_load_lds((const unsigned*)(vb_ + voA), (ALAS unsigned*)(lds + R_V + (s) * 16384 + wid * 1024), 16, 0, 0); \
    __builtin_amdgcn_global_load_lds((const unsigned*)(vb_ + voB), (ALAS unsigned*)(lds + R_V + (s) * 16384 + 8192 + wid * 1024), 16, 0, 0); \
    __builtin_amdgcn_global_load_lds((const unsigned*)(rb_ + kro), (ALAS unsigned*)(lds + R_KR + (s) * 8192 + wid * 1024), 16, 0, 0); } while (0)
#define KLD(d0, row32) (*(const ALAS bf16x8*)(Ks + kl0 + (row32) * 8192 + ((((d0) * 16 + hi * 8) * 2) ^ kx)))
#define KRLD(d0, row32) (*(const ALAS bf16x8*)(Krs + krl0 + (row32) * 4096 + ((((d0) * 16 + hi * 8) * 2) ^ krx)))
  f32x16 p0, p1; float mn, al; bf16x8 pa0, pa1, pa2, pa3;
  DMA(0, 0); DMA(1, 1);
  int s = 0;
  for (int j = 0; j < NT; ++j) {
    if (j + 1 < NT) asm volatile("s_waitcnt vmcnt(5)" ::: "memory"); else asm volatile("s_waitcnt vmcnt(0)" ::: "memory");
    __builtin_amdgcn_s_barrier(); asm volatile("" ::: "memory");
    if (j + 2 < NT) { const int s2 = s == 0 ? 2 : s - 1; DMA(j + 2, s2); }
    SBAR();
    { const ALAS char* Ks = lds + R_K + s * 16384; const ALAS char* Krs = lds + R_KR + s * 8192;
      p0 = f32x16{}; p1 = f32x16{};
      bf16x8 b0 = KLD(0, 0), b1 = KLD(0, 1);
#pragma unroll
      for (int d0 = 0; d0 < 12; ++d0) {
        bf16x8 n0, n1;
        if (d0 + 1 < 8) { n0 = KLD(d0 + 1, 0); n1 = KLD(d0 + 1, 1); } else if (d0 + 1 < 12) { n0 = KRLD(d0 + 1 - 8, 0); n1 = KRLD(d0 + 1 - 8, 1); }
        p0 = __builtin_amdgcn_mfma_f32_32x32x16_bf16(b0, qr[d0], p0, 0, 0, 0);
        p1 = __builtin_amdgcn_mfma_f32_32x32x16_bf16(b1, qr[d0], p1, 0, 0, 0);
        if (d0 + 1 < 12) { b0 = n0; b1 = n1; }
      } }
    partialSM(p0, p1, m_reg, mn, al, C, thr_raw);
    if (__any(al < 1.f)) { if (hi == 0) al_l[r32] = al; asm volatile("s_waitcnt lgkmcnt(0)" ::: "memory");
#pragma unroll
      for (int d = 0; d < 4; ++d)
#pragma unroll
        for (int r = 0; r < 16; ++r) o[d][r] *= al_l[crow(r, hi)]; }
    finishSM(p0, p1, al, l_reg, pa0, pa1, pa2, pa3); SBAR();
    pv_d0(o, vbl + s * 16384, pa0, pa1, pa2, pa3);
    SBAR();
    s = s == 2 ? 0 : s + 1;
  }
  if (hi == 0) li_l[r32] = l_reg; asm volatile("s_waitcnt lgkmcnt(0)" ::: "memory");
  bf16_t* Ow = Ob + (unsigned)(wid * 32 * ldo + r32);
#pragma unroll
  for (int r = 0; r < 16; ++r) { const int orow = crow(r, hi); const float rl = __builtin_amdgcn_rcpf(li_l[orow]);
#pragma unroll
    for (int d0 = 0; d0 < 4; ++d0) Ow[(unsigned)(orow * ldo + d0 * 32)] = (bf16_t)(cvtpk(o[d0][r] * rl, 0.f) & 0xffffu); }
  __syncthreads();
#undef DMA
#undef KLD
#undef KRLD
}
}
#define LAS __attribute__((address_space(3)))
typedef unsigned short bf16;
typedef unsigned v4u __attribute__((ext_vector_type(4)));
typedef float f32x4 __attribute__((ext_vector_type(4)));
constexpr int NWAVES = 8;
#ifndef PHMASK
#define PHMASK 0xFFFF
#endif
#define PHON(k) constexpr ((PHMASK >> (k)) & 1)
#ifndef REP_MASK
#define REP_MASK 0
#endif
#define REPS(k) for (int rep_ = 0; rep_ < (((REP_MASK >> (k)) & 1) ? 2 : 1); ++rep_)
constexpr int LDS_BYTES = 131072 + 1024;
__device__ __forceinline__ unsigned pk2(float lo, float hi) { unsigned r; asm volatile("v_cvt_pk_bf16_f32 %0, %1, %2" : "=v"(r) : "v"(lo), "v"(hi)); return r; }
__device__ __forceinline__ float bflo(unsigned w) { return __uint_as_float(w << 16); }
__device__ __forceinline__ float bfhi(unsigned w) { return __uint_as_float(w & 0xffff0000u); }
__device__ __forceinline__ float wave_sum(float v) {
#pragma unroll
    for (int o = 1; o < 64; o <<= 1) v += __shfl_xor(v, o);
    return v;
}
__device__ __forceinline__ int map_win(int n) {
    if (n < 3072) { const int base = n < 1536 ? 0 : 1536, r = n - base, head = r >> 7, pc = r & 127; return base + head * 128 + (pc >> 1) + (pc & 1) * 64; }
    if (n < 5632) return n;
    if (n < 9728) return n + 64;
    const int pc = n - 9728; if (pc < 64) return 5632 + (pc >> 1) + (pc & 1) * 32;
    return -1;
}
__device__ __forceinline__ int map_wuq(int n) {
    if (n < 2048) return (n >> 7) * 192 + (n & 127);
    const int r = n - 2048, head = r >> 6, pc = r & 63; return head * 192 + 128 + (pc >> 1) + (pc & 1) * 32;
}
typedef float f32x2_ __attribute__((ext_vector_type(2)));
template <int MAP>
__device__ __forceinline__ void transpose_item(const float* __restrict__ W, int K, int N, int Np, const float* __restrict__ gain, bf16* __restrict__ WT, LAS float* scr, int item, int lane) {
    const int nblk = Np / 32, kb = item / nblk, nb = item % nblk, k0 = 64 * kb, n0 = 32 * nb;
    f32x4 v[8];
#pragma unroll
    for (int i = 0; i < 8; ++i) {
        const int idx = i * 64 + lane, kk = idx >> 3, np = n0 + (idx & 7) * 4;
        const float* row = W + (size_t)(k0 + kk) * N;
        int col = np, ilv = -1;
        int half = 64;
        if (MAP == 1) {
            if (np < 3072) { const int base = np < 1536 ? 0 : 1536, r = np - base; ilv = base + (r >> 7) * 128 + ((r & 127) >> 1); }
            else if (np < 5632) col = np;
            else if (np < 9728) col = np + 64;
            else if (np < 9792) { ilv = 5632 + ((np - 9728) >> 1); half = 32; }
            else col = -1;
        } else if (MAP == 2) {
            if (np < 2048) col = (np >> 7) * 192 + (np & 127);
            else { const int r = np - 2048; ilv = (r >> 6) * 192 + 128 + ((r & 63) >> 1); half = 32; }
        }
        if (ilv >= 0) { const f32x2_ a = __builtin_nontemporal_load((const f32x2_*)(row + ilv)), b = __builtin_nontemporal_load((const f32x2_*)(row + ilv + half)); v[i] = (f32x4){a.x, b.x, a.y, b.y}; }
        else if (col >= 0) v[i] = __builtin_nontemporal_load((const f32x4*)(row + col));
        else v[i] = (f32x4){0.f, 0.f, 0.f, 0.f};
    }
#pragma unroll
    for (int i = 0; i < 8; ++i) {
        const int idx = i * 64 + lane, kk = idx >> 3, c4 = (idx & 7) * 4;
        const float g = gain ? gain[k0 + kk] : 1.f;
        scr[kk * 33 + c4 + 0] = v[i].x * g; scr[kk * 33 + c4 + 1] = v[i].y * g; scr[kk * 33 + c4 + 2] = v[i].z * g; scr[kk * 33 + c4 + 3] = v[i].w * g;
    }
    asm volatile("s_waitcnt lgkmcnt(0)" ::: "memory");
    const int c = lane & 7;
#pragma unroll
    for (int j = 0; j < 4; ++j) { const int n = (lane >> 3) + 8 * j; const LAS float* s = scr + (8 * c) * 33 + n;
        v4u o; o.x = pk2(s[0 * 33], s[1 * 33]); o.y = pk2(s[2 * 33], s[3 * 33]); o.z = pk2(s[4 * 33], s[5 * 33]); o.w = pk2(s[6 * 33], s[7 * 33]);
        *(v4u*)(WT + (size_t)(n0 + n) * K + k0 + 8 * c) = o; }
    asm volatile("s_waitcnt lgkmcnt(0)" ::: "memory");
}
__device__ __forceinline__ void rms_rows(const float* __restrict__ x, bf16* __restrict__ H, int gw, int NGW, int lane) {
    for (int m = gw; m < S_; m += NGW) {
        const f32x4* xr = (const f32x4*)(x + (size_t)m * DM) + lane; f32x4 v[8]; float s = 0.f;
#pragma unroll
        for (int j = 0; j < 8; ++j) { v[j] = xr[64 * j]; s += (v[j].x * v[j].x + v[j].y * v[j].y) + (v[j].z * v[j].z + v[j].w * v[j].w); }
        const float rstd = 1.f / sqrtf(wave_sum(s) * (1.f / DM) + EPS_);
        unsigned long long* o8 = (unsigned long long*)(H + (size_t)m * DM) + lane;
#pragma unroll
        for (int j = 0; j < 8; ++j) o8[64 * j] = (unsigned long long)pk2(v[j].x * rstd, v[j].y * rstd) | ((unsigned long long)pk2(v[j].z * rstd, v[j].w * rstd) << 32);
    }
}
__device__ __forceinline__ void rstd_rows_b(const bf16* __restrict__ X, float* __restrict__ R, int gw, int NGW, int lane) {
    for (int m = gw; m < S_; m += NGW) {
        const v4u* xr = (const v4u*)(X + (size_t)m * DM) + lane; float s = 0.f;
#pragma unroll
        for (int j = 0; j < 4; ++j) { const v4u w = xr[64 * j];
            const float a0 = bflo(w.x), a1 = bfhi(w.x), a2 = bflo(w.y), a3 = bfhi(w.y), a4 = bflo(w.z), a5 = bfhi(w.z), a6 = bflo(w.w), a7 = bfhi(w.w);
            s += (a0 * a0 + a1 * a1) + (a2 * a2 + a3 * a3) + (a4 * a4 + a5 * a5) + (a6 * a6 + a7 * a7); }
        const float rstd = 1.f / sqrtf(wave_sum(s) * (1.f / DM) + EPS_);
        if (lane == 0) R[m] = rstd;
    }
}
__device__ __forceinline__ void rms_rows_b(const bf16* __restrict__ X, bf16* __restrict__ H, int gw, int NGW, int lane) {
    for (int m = gw; m < S_; m += NGW) {
        const v4u* xr = (const v4u*)(X + (size_t)m * DM) + lane; v4u w[4]; float s = 0.f;
#pragma unroll
        for (int j = 0; j < 4; ++j) { w[j] = xr[64 * j];
            const float a0 = bflo(w[j].x), a1 = bfhi(w[j].x), a2 = bflo(w[j].y), a3 = bfhi(w[j].y), a4 = bflo(w[j].z), a5 = bfhi(w[j].z), a6 = bflo(w[j].w), a7 = bfhi(w[j].w);
            s += (a0 * a0 + a1 * a1) + (a2 * a2 + a3 * a3) + (a4 * a4 + a5 * a5) + (a6 * a6 + a7 * a7); }
        const float rstd = 1.f / sqrtf(wave_sum(s) * (1.f / DM) + EPS_);
        v4u* hr = (v4u*)(H + (size_t)m * DM) + lane;
#pragma unroll
        for (int j = 0; j < 4; ++j) { v4u o; o.x = pk2(bflo(w[j].x) * rstd, bfhi(w[j].x) * rstd); o.y = pk2(bflo(w[j].y) * rstd, bfhi(w[j].y) * rstd);
            o.z = pk2(bflo(w[j].z) * rstd, bfhi(w[j].z) * rstd); o.w = pk2(bflo(w[j].w) * rstd, bfhi(w[j].w) * rstd); hr[64 * j] = o; }
    }
}
__device__ __forceinline__ void rms512_inplace(bf16* __restrict__ A, int gw, int NGW, int lane) {
    for (int m = gw; m < S_; m += NGW) {
        v4u* p = (v4u*)(A + (size_t)m * 512) + lane; const v4u w = *p;
        float f[8] = {bflo(w.x), bfhi(w.x), bflo(w.y), bfhi(w.y), bflo(w.z), bfhi(w.z), bflo(w.w), bfhi(w.w)}; float s = 0.f;
#pragma unroll
        for (int e = 0; e < 8; ++e) s += f[e] * f[e];
        const float rstd = 1.f / sqrtf(wave_sum(s) * (1.f / 512) + EPS_);
        v4u o; o.x = pk2(f[0] * rstd, f[1] * rstd); o.y = pk2(f[2] * rstd, f[3] * rstd); o.z = pk2(f[4] * rstd, f[5] * rstd); o.w = pk2(f[6] * rstd, f[7] * rstd); *p = o;
    }
}
#define XB_TMO      128
#define XB_XCNT(j)  (256  + 64 * (j))
#define XB_XSUB(j)  (1280 + 64 * (j))
#define XB_XGEN(j)  (2304 + 64 * (j))
#define XB_TOP      3328
#define XB_TOPGEN   3392
#define XCD_BAR_WORDS 3456
#define XB_SPIN_CAP (1u << 23)

__device__ __forceinline__ unsigned xb_ld(unsigned* p)              { return __hip_atomic_load(p, __ATOMIC_RELAXED, __HIP_MEMORY_SCOPE_AGENT); }
__device__ __forceinline__ unsigned xb_add(unsigned* p, unsigned v) { return __hip_atomic_fetch_add(p, v, __ATOMIC_RELAXED, __HIP_MEMORY_SCOPE_AGENT); }
__device__ __forceinline__ unsigned xb_xcc_id() { return (unsigned)__builtin_amdgcn_s_getreg((3 << 11) | 20) & 0xFu; }
#define XB_SPIN(cond, bar) do { unsigned _sp = 0; while (cond) { __builtin_amdgcn_s_sleep(1); \
    if ((++_sp & 255u) == 0u) { if (xb_ld(&(bar)[XB_TMO])) break; if (_sp > XB_SPIN_CAP) { atomicAdd(&(bar)[XB_TMO], 1u); break; } } } } while (0)

struct XcdBarrier {
    unsigned* bar; unsigned x;
    volatile LAS unsigned* st;
};

__device__ __forceinline__ XcdBarrier xcd_barrier_post(unsigned* bar, volatile LAS unsigned* st) {
    XcdBarrier b; b.bar = bar; b.x = xb_xcc_id(); b.st = st;
    if (threadIdx.x == 0) (void)xb_add(&bar[XB_XCNT(b.x)], 1u);
    return b;
}
__device__ __forceinline__ void xcd_barrier_complete(unsigned* bar, unsigned x, unsigned& nloc, unsigned& nx) {
    const unsigned G = gridDim.x * gridDim.y * gridDim.z;
    unsigned sum, cnt, mine, sp = 0u;
    for (;;) {
        sum = 0u; cnt = 0u; mine = 0u;
#pragma unroll
        for (unsigned j = 0; j < 16; ++j) { const unsigned c = xb_ld(&bar[XB_XCNT(j)]); sum += c; cnt += (c > 0u) ? 1u : 0u; mine = (j == x) ? c : mine; }
        if (sum == G) break;
        __builtin_amdgcn_s_sleep(1);
        if ((++sp & 255u) == 0u) { if (xb_ld(&bar[XB_TMO])) break; if (sp > XB_SPIN_CAP) { atomicAdd(&bar[XB_TMO], 1u); break; } }
    }
    nloc = mine > 0u ? mine : 1u; nx = cnt > 0u ? cnt : 1u;
}

__device__ __forceinline__ void xcd_barrier(const XcdBarrier& b) {
    asm volatile("s_waitcnt vmcnt(0)" ::: "memory");
    __syncthreads();
    if (threadIdx.x == 0) {
        unsigned* bar = b.bar;
        __builtin_amdgcn_s_waitcnt(0);
        unsigned nloc = b.st[0], nx = b.st[1];
        if (nloc == 0u) { xcd_barrier_complete(bar, b.x, nloc, nx); b.st[0] = nloc; b.st[1] = nx; }
        const unsigned old = xb_add(&bar[XB_XSUB(b.x)], 1u);
        const unsigned gen = old / nloc;
        if (old + 1u == (gen + 1u) * nloc) {
            __builtin_amdgcn_fence(__ATOMIC_RELEASE, "agent");
            asm volatile("s_waitcnt vmcnt(0)" ::: "memory");
            const unsigned og = xb_add(&bar[XB_TOP], 1u);
            const unsigned tg = og / nx;
            if (og + 1u == (tg + 1u) * nx) xb_add(&bar[XB_TOPGEN], 1u);
            else XB_SPIN(xb_ld(&bar[XB_TOPGEN]) == tg, bar);
            __builtin_amdgcn_fence(__ATOMIC_ACQUIRE, "agent");
            xb_add(&bar[XB_XGEN(b.x)], 1u);
            asm volatile("s_waitcnt vmcnt(0)" ::: "memory");
        } else {
            XB_SPIN(xb_ld(&bar[XB_XGEN(b.x)]) == gen, bar);
            __builtin_amdgcn_fence(__ATOMIC_ACQUIRE, "agent");
            asm volatile("s_waitcnt vmcnt(0)" ::: "memory");
        }
    }
    __syncthreads();
}

struct Args { const float* in[18]; float* out; unsigned char* ws; int ph_lo, ph_hi; };
constexpr int PH_PER_LAYER = 11, PH_TOTAL = DEPTH_ * PH_PER_LAYER + 1;

#define GAS __attribute__((address_space(1)))
#define WB(off) ((bf16*)(GAS bf16*)(ws + (off)))
#define WF(off) ((float*)(GAS float*)(ws + (off)))
#define GIN(k) ((const float*)(const GAS float*)ap->in[k])
#define GOUT ((float*)(GAS float*)ap->out)
#define SEAM(k) do { RELOAD(); if ((k) + 1 < ap->ph_hi) { if ((k) == 0) { __syncthreads(); grid.sync(); } else xcd_barrier(xbar); } RELOAD(); } while (0)
#define GEMM_PHASE(MODE, Aoff, Boff, N_, K_, F0, FO) do { pg8::Gemm g{WB(Aoff), WB(Boff), S_, (N_), (K_)}; int G_ = gridDim.x, bx_ = blockIdx.x; asm volatile("" : "+s"(G_), "+s"(bx_)); pg8::StaticOrder SO; SO.init(S_, (N_), G_, bx_); \
    pg8::Epi<pg8::MODE> E{{ws, (F0), (FO)}}; pg8::gemm_phase<pg8::Epi<pg8::MODE>, pg8::StaticOrder, true, true>((LAS unsigned char*)lds, g, SO, E); } while (0)
#define GEMM_PHASE_A(MODE, Aptr, Boff, N_, K_, F0, FO) do { pg8::Gemm g{(Aptr), WB(Boff), S_, (N_), (K_)}; int G_ = gridDim.x, bx_ = blockIdx.x; asm volatile("" : "+s"(G_), "+s"(bx_)); pg8::StaticOrder SO; SO.init(S_, (N_), G_, bx_); \
    pg8::Epi<pg8::MODE> E{{ws, (F0), (FO)}}; pg8::gemm_phase<pg8::Epi<pg8::MODE>, pg8::StaticOrder, true, true>((LAS unsigned char*)lds, g, SO, E); } while (0)

__global__ void __launch_bounds__(NWAVES * 64, 2) mega_fwd(Args args) {
    extern __shared__ __attribute__((aligned(16))) unsigned char lds[];
    cg::grid_group grid = cg::this_grid();
    { volatile LAS unsigned* st0 = (volatile LAS unsigned*)((LAS unsigned char*)lds + 131072); if (threadIdx.x < 64) st0[threadIdx.x] = 0u; }
    __syncthreads();
    XcdBarrier xbar = xcd_barrier_post((unsigned*)args.ws, (volatile LAS unsigned*)((LAS unsigned char*)lds + 131072));
    typedef const __attribute__((address_space(4))) Args* ArgsP; ArgsP ap = (ArgsP)__builtin_amdgcn_kernarg_segment_ptr();
    unsigned char* ws;
#define RELOAD() do { asm volatile("" : "+s"(ap)); ws = ap->ws; asm volatile("" : "+s"(ws)); } while (0)
#define TIDS int tid_ = threadIdx.x, G_ = gridDim.x, bx_ = blockIdx.x; asm volatile("" : "+v"(tid_), "+s"(G_), "+s"(bx_)); const int tid = tid_, lane = tid & 63, wave = __builtin_amdgcn_readfirstlane(tid >> 6); const int G = G_, bx = bx_; \
    const int gw = bx * NWAVES + wave, NGW = G * NWAVES; const long gt = (long)bx * 512 + tid, NGT = (long)G * 512; (void)lane; (void)gw; (void)NGW; (void)gt; (void)NGT;
#pragma nounroll
    for (int l = 0; l < DEPTH_; ++l) {
#define pb (l * PH_PER_LAYER)
#define IN(k) (ap->ph_lo <= pb + (k) && pb + (k) < ap->ph_hi)
        RELOAD();
        if (IN(0)) { if PHON(0) REPS(0) {
            TIDS
            const float *norm_mix = GIN(2) + (size_t)l * DM, *w_in = GIN(3) + (size_t)l * DM * NIN, *norm_q = GIN(5) + (size_t)l * QLORA, *w_uq = GIN(6) + (size_t)l * QLORA * 3072,
                        *norm_kv = GIN(7) + (size_t)l * KVLORA, *w_ukv = GIN(8) + (size_t)l * KVLORA * 4096, *w_oa = GIN(9) + (size_t)l * 512 * DM, *w_ob = GIN(10) + (size_t)l * DM * DM,
                        *w_out = GIN(11) + (size_t)l * DM * DM, *norm_ffn = GIN(12) + (size_t)l * DM, *w_up = GIN(13) + (size_t)l * DM * 2 * DFF, *w_down = GIN(16) + (size_t)l * DFF * DM;
            LAS float* scr = (LAS float*)((LAS unsigned char*)lds + wave * 16384);
            constexpr int I_IN = (DM / 64) * (NINP / 32), I_UQ = (512 / 64) * (3072 / 32), I_UKV = (512 / 64) * (4096 / 32), I_OA = (512 / 64) * (DM / 32), I_OB = (DM / 64) * (DM / 32), I_OUT = I_OB,
                          I_UP = (DM / 64) * (2 * DFF / 32), I_DN = (DFF / 64) * (DM / 32);
            constexpr int NITEMS = I_IN + I_UQ + I_UKV + I_OA + I_OB + I_OUT + I_UP + I_DN;
            for (int it = gw; it < NITEMS; it += NGW) {
                int r = it;
                if (r < I_IN) { transpose_item<1>(w_in, DM, NIN, NINP, norm_mix, WB(WS_WIN), scr, r, lane); continue; } r -= I_IN;
                if (r < I_UQ) { transpose_item<2>(w_uq, 512, 3072, 3072, norm_q, WB(WS_WUQ), scr, r, lane); continue; } r -= I_UQ;
                if (r < I_UKV) { transpose_item<0>(w_ukv, 512, 4096, 4096, norm_kv, WB(WS_WUKV), scr, r, lane); continue; } r -= I_UKV;
                if (r < I_OA) { transpose_item<0>(w_oa, 512, DM, DM, nullptr, WB(WS_WOA), scr, r, lane); continue; } r -= I_OA;
                if (r < I_OB) { transpose_item<0>(w_ob, DM, DM, DM, nullptr, WB(WS_WOB), scr, r, lane); continue; } r -= I_OB;
                if (r < I_OUT) { transpose_item<0>(w_out, DM, DM, DM, nullptr, WB(WS_WOUT), scr, r, lane); continue; } r -= I_OUT;
                if (r < I_UP) { transpose_item<0>(w_up, DM, 2 * DFF, 2 * DFF, norm_ffn, WB(WS_WUP), scr, r, lane); continue; } r -= I_UP;
                transpose_item<0>(w_down, DFF, DM, DM, nullptr, WB(WS_WDN), scr, r, lane);
            }
            if (l == 0) {
                const int* positions = (const int*)GIN(1);
                for (long i = gt; i < (long)S_ * 96; i += NGT) {
                    const int s = (int)(i / 96), j = (int)(i % 96); const double pos = (double)positions[s];
                    const bool isA = j < 64; const int e = isA ? j : j - 64;
                    double base = isA ? 0.8659643233600653 : 0.7498942093324559, inv = 1.0;
#pragma unroll
                    for (int bit = 0; bit < 6; ++bit) { if ((e >> bit) & 1) inv *= base; base *= base; }
                    double t = pos * inv * 0.15915494309189535; t -= rint(t);
                    const float tf = (float)t;
                    float* dst = isA ? WF(WS_ROPEA) + ((size_t)s * 64 + e) * 2 : WF(WS_ROPEB) + ((size_t)s * 32 + e) * 2;
                    dst[0] = __builtin_amdgcn_cosf(tf); dst[1] = __builtin_amdgcn_sinf(tf);
                }
            }
            if (l == 0) { rms_rows(GIN(0), WB(WS_H), gw, NGW, lane); for (long i = gt; i < S_; i += NGT) WF(WS_RSTD)[i] = 1.f; } else rstd_rows_b((const bf16*)(GAS bf16*)((GAS unsigned char*)ap->out + 67108864), WF(WS_RSTD), gw, NGW, lane);
        } SEAM(pb + 0); }
        if (IN(1)) { if PHON(1) REPS(1) {
            if (l == 0) GEMM_PHASE(EP_IN, WS_H, WS_WIN, NINP, DM, GIN(4) + (size_t)l * 4096, nullptr); else GEMM_PHASE_A(EP_IN, (const bf16*)(GAS bf16*)((GAS unsigned char*)ap->out + 67108864), WS_WIN, NINP, DM, GIN(4) + (size_t)l * 4096, nullptr);
        } SEAM(pb + 1); }
        if (IN(2)) { if PHON(2) {
            TIDS
            rms512_inplace(WB(WS_QL), gw, NGW, lane); rms512_inplace(WB(WS_KVL), gw, NGW, lane);
            const float scale = 0.08838834764831845f, C = scale * 1.4426950408889634f;
            REPS(2) for (int u = bx; u < 768; u += G) {
                const int g = u >> 8, rem = u & 255, head = rem >> 6, idx = rem & 63;
                const int dsh = 2 * g, d = 1 << dsh, L = S_ >> dsh, nqb = L >> 8, r = idx / nqb, qb = idx % nqb, t0 = qb * 256;
                int ks = t0 - 64; if (ks < 0) ks = 0; if (ks > L - 384) ks = L - 384;
                const int pitch = d * WA; const int hc = (g * 4 + head) * 128;
                const bf16* Qp = WB(WS_QA) + (size_t)(r + d * t0) * WA + hc; const bf16* Kp = WB(WS_KA) + (size_t)(r + d * ks) * WA + hc; const bf16* Vp = WB(WS_VA) + (size_t)(r + d * ks) * WA + hc;
                bf16* Op = WB(WS_OG) + (size_t)(r + d * t0) * WA + hc; float* Lp = WF(WS_LSE) + (size_t)(r + d * t0) * 12 + g * 4 + head;
                att::attn_unit<0, true>(Qp, pitch, Kp, pitch, Kp, Vp, pitch, Op, pitch, Lp, d * 12, 6, t0 - ks, C, 8.f / scale, scale, (char*)lds);
            }
        } SEAM(pb + 2); }
        if (IN(3)) { if PHON(3) REPS(3) {
            GEMM_PHASE(EP_CQ, WS_QL, WS_WUQ, 3072, 512, nullptr, nullptr);
            GEMM_PHASE(EP_CKV, WS_KVL, WS_WUKV, 4096, 512, nullptr, nullptr);
            TIDS
            const float* LSE = WF(WS_LSE); const bf16* OG = WB(WS_OG); bf16* OA = WB(WS_OA);
            for (long i = gt; i < (long)S_ * 64; i += NGT) {
                const int s = (int)(i >> 6), hh = (int)(i >> 4) & 3, ch = (int)i & 15;
                const float l0 = LSE[(size_t)s * 12 + hh], l1 = LSE[(size_t)s * 12 + 4 + hh], l2 = LSE[(size_t)s * 12 + 8 + hh];
                const float mx = fmaxf(l0, fmaxf(l1, l2)); float w0 = __expf(l0 - mx), w1 = __expf(l1 - mx), w2 = __expf(l2 - mx); const float inv = 1.f / (w0 + w1 + w2); w0 *= inv; w1 *= inv; w2 *= inv;
                const v4u a = *(const v4u*)(OG + (size_t)s * WA + hh * 128 + ch * 8), b = *(const v4u*)(OG + (size_t)s * WA + (4 + hh) * 128 + ch * 8), c = *(const v4u*)(OG + (size_t)s * WA + (8 + hh) * 128 + ch * 8);
                v4u o;
                o.x = pk2(w0 * bflo(a.x) + w1 * bflo(b.x) + w2 * bflo(c.x), w0 * bfhi(a.x) + w1 * bfhi(b.x) + w2 * bfhi(c.x));
                o.y = pk2(w0 * bflo(a.y) + w1 * bflo(b.y) + w2 * bflo(c.y), w0 * bfhi(a.y) + w1 * bfhi(b.y) + w2 * bfhi(c.y));
                o.z = pk2(w0 * bflo(a.z) + w1 * bflo(b.z) + w2 * bflo(c.z), w0 * bfhi(a.z) + w1 * bfhi(b.z) + w2 * bfhi(c.z));
                o.w = pk2(w0 * bflo(a.w) + w1 * bflo(b.w) + w2 * bflo(c.w), w0 * bfhi(a.w) + w1 * bfhi(b.w) + w2 * bfhi(c.w));
                *(v4u*)(OA + (size_t)s * 512 + hh * 128 + ch * 8) = o;
            }
        } SEAM(pb + 3); }
        if (IN(4)) { if PHON(4) REPS(4) {
            int G = gridDim.x, bx = blockIdx.x; asm volatile("" : "+s"(G), "+s"(bx));
            const float scale = 0.07216878364870323f, C = scale * 1.4426950408889634f;
#if defined(ATT_PROBE)
            for (int u = bx; u < 1024; u += G) {
                const int xc = u & 7, rest = u >> 3, pair = (rest >> 5) * 8 + xc, head = pair >> 1, qb = (pair & 1) * 32 + (rest & 31);
                att::attn_unit2<4, ATT_PROBE>(WB(WS_QB) + (size_t)qb * 256 * 3072 + head * 192, 3072, WB(WS_KN) + head * 128, 2048, WB(WS_KPE), WB(WS_VB) + head * 128, 2048,
                                   WB(WS_T) + (size_t)qb * 256 * 2048 + head * 128, 2048, S_ / 64, C, 8.f / scale, (char*)lds);
            }
            __syncthreads(); grid.sync();
#endif
            for (int u = bx; u < 1024; u += G) {
                const int xc = u & 7, rest = u >> 3, pair = (rest >> 5) * 8 + xc, head = pair >> 1, qb = (pair & 1) * 32 + (rest & 31);
                att::attn_unit7((const unsigned char*)(GAS unsigned char*)(ws + WS_QB) + (size_t)qb * 256 * 3072 + head * 192, 3072, (const unsigned char*)(GAS unsigned char*)(ws + WS_KN) + head * 128, 2048,
                                (const unsigned char*)(GAS unsigned char*)(ws + WS_KPE), (const unsigned char*)(GAS unsigned char*)(ws + WS_VB) + (size_t)head * (S_ / 64) * 8192,
                                WB(WS_H) + (size_t)qb * 256 * 2048 + head * 128, 2048, S_ / 64, C, 1.4426950408889634f, (char*)lds);
            }
#ifndef NO_YA
            GEMM_PHASE(EP_YA, WS_OA, WS_WOA, DM, 512, nullptr, nullptr);
#endif
        } SEAM(pb + 4); }
        if (IN(5)) { if PHON(5) REPS(5) {
            GEMM_PHASE(EP_YB, WS_H, WS_WOB, DM, DM, nullptr, nullptr);
        } SEAM(pb + 5); }
        if (IN(6)) { if PHON(6) {
            GEMM_PHASE(EP_RES, WS_MERGED, WS_WOUT, DM, DM, (l == 0 ? GIN(0) : (const float*)nullptr), GOUT);
        } SEAM(pb + 6); }
        if (IN(7)) { if PHON(7) { TIDS rstd_rows_b((const bf16*)(GAS bf16*)((GAS unsigned char*)ap->out + 67108864), WF(WS_RSTD), gw, NGW, lane); } SEAM(pb + 7); }
        if (IN(8)) { if PHON(8) REPS(8) {
            GEMM_PHASE_A(EP_U, (const bf16*)(GAS bf16*)((GAS unsigned char*)ap->out + 67108864), WS_WUP, 2 * DFF, DM, nullptr, nullptr);
        } SEAM(pb + 8); }
        if (IN(9)) { if PHON(9) REPS(9) {
            TIDS
            const float *cw = GIN(14) + (size_t)l * 3 * 2 * DFF, *cb = GIN(15) + (size_t)l * 2 * DFF; const bf16* U = WB(WS_U); bf16* GG = WB(WS_G);
            constexpr int NCG = DFF / 8;
            const int nsl = (int)(NGT / NCG), rps = (S_ + nsl - 1) / nsl, cgp = (int)(gt % NCG), sl = (int)(gt / NCG);
            if (sl < nsl && sl * rps < S_) {
                const int c = cgp * 8, sb = sl * rps, se = (sb + rps < S_) ? sb + rps : S_;
                float wa[3][8], wb[3][8], ba[8], bb[8];
#pragma unroll
                for (int t = 0; t < 3; ++t)
#pragma unroll
                    for (int e = 0; e < 8; ++e) { wa[t][e] = cw[(size_t)t * 2 * DFF + c + e]; wb[t][e] = cw[(size_t)t * 2 * DFF + DFF + c + e]; }
#pragma unroll
                for (int e = 0; e < 8; ++e) { ba[e] = cb[c + e]; bb[e] = cb[DFF + c + e]; }
                const v4u z = {0u, 0u, 0u, 0u};
#define LDU(s, off) (((s) >= 0 && (s) < S_) ? __builtin_nontemporal_load((const v4u*)(U + (size_t)(s) * 2 * DFF + (off) + c)) : z)
                v4u ra[6], rb[6], na[4], nb[4];
#pragma unroll
                for (int k = 0; k < 6; ++k) { ra[k] = LDU(sb - 1 + k, 0); rb[k] = LDU(sb - 1 + k, DFF); }
                for (int s = sb; s < se; s += 4) {
#pragma unroll
                    for (int k = 0; k < 4; ++k) { na[k] = LDU(s + 5 + k, 0); nb[k] = LDU(s + 5 + k, DFF); }
#define CV(e, P, Cc, Nn, W, Bv) (Bv[e] + W[0][e] * ((e & 1) ? bfhi(P[e >> 1]) : bflo(P[e >> 1])) + W[1][e] * ((e & 1) ? bfhi(Cc[e >> 1]) : bflo(Cc[e >> 1])) + W[2][e] * ((e & 1) ? bfhi(Nn[e >> 1]) : bflo(Nn[e >> 1])))
#pragma unroll
                    for (int k = 0; k < 4; ++k) {
                        if (s + k < se) {
                            float ga[8];
#pragma unroll
                            for (int e = 0; e < 8; ++e) { const float ua = CV(e, ra[k], ra[k + 1], ra[k + 2], wa, ba), ub = CV(e, rb[k], rb[k + 1], rb[k + 2], wb, bb); ga[e] = ua * __builtin_amdgcn_rcpf(1.f + __expf(-ua)) * ub; }
                            v4u o; o.x = pk2(ga[0], ga[1]); o.y = pk2(ga[2], ga[3]); o.z = pk2(ga[4], ga[5]); o.w = pk2(ga[6], ga[7]);
                            *(v4u*)(GG + (size_t)(s + k) * DFF + c) = o;
                        }
                    }
#undef CV
                    ra[0] = ra[4]; ra[1] = ra[5]; rb[0] = rb[4]; rb[1] = rb[5];
#pragma unroll
                    for (int k = 0; k < 4; ++k) { ra[2 + k] = na[k]; rb[2 + k] = nb[k]; }
                }
#undef LDU
            }
        } SEAM(pb + 9); }
        if (IN(10)) { if PHON(10) {
            GEMM_PHASE(EP_RES, WS_G, WS_WDN, DM, DFF, (const float*)nullptr, GOUT);
        } SEAM(pb + 10); }
#undef IN
#undef pb
    }
    RELOAD();
    if (ap->ph_lo <= PH_TOTAL - 1 && PH_TOTAL - 1 < ap->ph_hi) {
        TIDS
        const bf16* XBp = (const bf16*)(GAS bf16*)((GAS unsigned char*)ap->out + 67108864); float* outp = GOUT; const float* gfin = GIN(17);
        v4u rw[8][4];
#pragma unroll
        for (int i = 0; i < 8; ++i) { const int row = gw + i * NGW;
#pragma unroll
            for (int j = 0; j < 4; ++j) rw[i][j] = row < S_ ? ((const v4u*)(XBp + (size_t)row * DM))[64 * j + lane] : (v4u){0u, 0u, 0u, 0u}; }
        asm volatile("s_waitcnt vmcnt(0)" ::: "memory");
        { XcdBarrier xb_; xb_.bar = (unsigned*)ws; xb_.x = xb_xcc_id(); xb_.st = (volatile LAS unsigned*)((LAS unsigned char*)lds + 131072); xcd_barrier(xb_); }
#pragma unroll
        for (int i = 0; i < 8; ++i) { const int row = gw + i * NGW; float s = 0.f;
#pragma unroll
            for (int j = 0; j < 4; ++j) { const v4u w = rw[i][j];
                const float a0 = bflo(w.x), a1 = bfhi(w.x), a2 = bflo(w.y), a3 = bfhi(w.y), a4 = bflo(w.z), a5 = bfhi(w.z), a6 = bflo(w.w), a7 = bfhi(w.w);
                s += (a0 * a0 + a1 * a1) + (a2 * a2 + a3 * a3) + (a4 * a4 + a5 * a5) + (a6 * a6 + a7 * a7); }
            const float rstd = 1.f / sqrtf(wave_sum(s) * (1.f / DM) + EPS_);
            if (row < S_) {
#pragma unroll
                for (int j = 0; j < 4; ++j) { const v4u w = rw[i][j]; const int c = (64 * j + lane) * 8; const f32x4 g0 = *(const f32x4*)(gfin + c), g1 = *(const f32x4*)(gfin + c + 4);
                    f32x4 o0 = {bflo(w.x), bfhi(w.x), bflo(w.y), bfhi(w.y)}, o1 = {bflo(w.z), bfhi(w.z), bflo(w.w), bfhi(w.w)};
                    __builtin_nontemporal_store(o0 * rstd * g0, (f32x4*)(outp + (size_t)row * DM + c)); __builtin_nontemporal_store(o1 * rstd * g1, (f32x4*)(outp + (size_t)row * DM + c + 4)); } }
        }
    }
}

extern "C" void kernel_launch(void* const* d_in, const int* in_sizes, int n_in, void* d_out, int out_size, void* d_ws, size_t ws_size, hipStream_t stream) {
    static int grid = 0;
    if (grid == 0) {
        if (n_in != 18 || out_size != S_ * DM || ws_size < WS_END) { fprintf(stderr, "kernel_launch: unexpected shapes (n_in %d out %d ws %zu)\n", n_in, out_size, ws_size); grid = -1; return; }
        int dev = 0, cus = 0, per_cu = 0;
        hipGetDevice(&dev); hipDeviceGetAttribute(&cus, hipDeviceAttributeMultiprocessorCount, dev);
        if (hipFuncSetAttribute((const void*)mega_fwd, hipFuncAttributeMaxDynamicSharedMemorySize, LDS_BYTES) != hipSuccess) { fprintf(stderr, "kernel_launch: hipFuncSetAttribute failed\n"); grid = -1; return; }
        if (hipOccupancyMaxActiveBlocksPerMultiprocessor(&per_cu, (const void*)mega_fwd, NWAVES * 64, LDS_BYTES) != hipSuccess || per_cu < 1) { fprintf(stderr, "kernel_launch: occupancy query gave %d\n", per_cu); per_cu = 1; }
        (void)hipGetLastError();
        grid = cus * 1;
    }
    if (grid < 0) return;
    if (hipMemsetAsync(d_ws, 0, 16384, stream) != hipSuccess) { fprintf(stderr, "kernel_launch: hipMemsetAsync failed\n"); return; }
    Args a{};
    for (int i = 0; i < 18; ++i) a.in[i] = (const float*)d_in[i];
    a.out = (float*)d_out; a.ws = (unsigned char*)d_ws;
#ifndef MK_SPLIT
    a.ph_lo = 0; a.ph_hi = PH_TOTAL;
    void* kargs[] = {&a};
    hipError_t e = hipLaunchCooperativeKernel((const void*)mega_fwd, dim3(grid), dim3(NWAVES * 64), kargs, LDS_BYTES, stream);
    if (e != hipSuccess) fprintf(stderr, "cooperative launch failed: %s (grid %d)\n", hipGetErrorString(e), grid);
#else
    for (int ph = 0; ph < PH_TOTAL; ++ph) { a.ph_lo = ph; a.ph_hi = ph + 1; hipLaunchKernelGGL(mega_fwd, dim3(grid), dim3(NWAVES * 64), LDS_BYTES, stream, a); }
#endif
}
```
